# Optimizing an MI355X kernel written in HIP

```python
import jax, jax.numpy as jnp
from jax import lax
import numpy as np

D_MODEL = 1024
BATCH = 16
SEQ = 2048
DEPTH = 4

GRID_W = 64
CTX_LEN = 256
N_HEADS = 8
QK_NOPE_DIM = 64
QK_ROPE_DIM = 32
QK_DIM = QK_NOPE_DIM + QK_ROPE_DIM
V_DIM = 64
Q_LORA_RANK = 384
KV_LORA_RANK = 256
ATTN_WIDTH = N_HEADS * V_DIM
LRU_WIDTH = D_MODEL - ATTN_WIDTH
LRU_BLOCKS = 8
LRU_BLOCK_DIM = LRU_WIDTH // LRU_BLOCKS
CONV_WIDTH = 4
LRU_C = 8.0
D_FF = -(-(8 * D_MODEL) // (3 * 256)) * 256
ROPE_BASE = 10000.0
Q_BLOCK = 128
EPS = 1e-6
IN_DIM = Q_LORA_RANK + KV_LORA_RANK + QK_ROPE_DIM + 2 * LRU_WIDTH
N_MOD = 6

kernel_name = "hybrid_mla_rglru_dit_block"


def _rmsnorm(x, g):
    xf = x.astype(jnp.float32)
    y = xf * lax.rsqrt(jnp.mean(xf * xf, axis=-1, keepdims=True) + EPS)
    return (y * g.astype(jnp.float32)).astype(x.dtype)


def _modulate(h, shift, scale):
    return h * (1.0 + scale) + shift


def _rope_1d(x, pos):
    m = x.shape[-1] // 2
    inv_freq = ROPE_BASE ** (-jnp.arange(m, dtype=jnp.float32) / m)
    ang = pos.astype(jnp.float32)[:, None] * inv_freq[None, :]
    cos = jnp.cos(ang)[:, None, :]
    sin = jnp.sin(ang)[:, None, :]
    xf = x.astype(jnp.float32)
    x1, x2 = xf[..., :m], xf[..., m:]
    return jnp.concatenate([x1 * cos - x2 * sin, x2 * cos + x1 * sin], axis=-1).astype(x.dtype)


def _axial_rope(x, row, col):
    half = QK_ROPE_DIM // 2
    x_nope = x[..., :QK_NOPE_DIM]
    x_r = x[..., QK_NOPE_DIM:QK_NOPE_DIM + half]
    x_c = x[..., QK_NOPE_DIM + half:]
    return jnp.concatenate([x_nope, _rope_1d(x_r, row), _rope_1d(x_c, col)], axis=-1)


def _mla_q(c_q, q_lora_g, w_uq, q_norm_g):
    B, T, _ = c_q.shape
    q = (_rmsnorm(c_q, q_lora_g) @ w_uq).reshape(B, T, N_HEADS, QK_DIM)
    return _rmsnorm(q, q_norm_g)


def _mla_kv(c_kv, k_r, kv_lora_g, w_ukv, k_norm_g):
    B, T, _ = c_kv.shape
    kv = (_rmsnorm(c_kv, kv_lora_g) @ w_ukv).reshape(B, T, N_HEADS, QK_NOPE_DIM + V_DIM)
    k_nope, v = kv[..., :QK_NOPE_DIM], kv[..., QK_NOPE_DIM:]
    k_rope = jnp.broadcast_to(k_r[:, :, None, :], (B, T, N_HEADS, QK_ROPE_DIM))
    k = jnp.concatenate([k_nope, k_rope], axis=-1)
    return _rmsnorm(k, k_norm_g), v


def _attend(q, k, v):
    s = jnp.einsum("bqhd,bkhd->bhqk", q, k).astype(jnp.float32) * (QK_DIM ** -0.5)
    p = jax.nn.softmax(s, axis=-1).astype(v.dtype)
    return jnp.einsum("bhqk,bkhd->bqhd", p, v)


def _latent_attention(q, k, v):
    B, S, H, Dk = q.shape
    n_blk = S // Q_BLOCK
    q_blk = q.reshape(B, n_blk, Q_BLOCK, H, Dk).transpose(1, 0, 2, 3, 4)
    o = lax.map(lambda qb: _attend(qb, k, v), q_blk)
    return o.transpose(1, 0, 2, 3, 4).reshape(B, S, H, V_DIM)


def _dwconv(u, w, b):
    T = u.shape[1]
    left = (CONV_WIDTH - 1) // 2
    up = jnp.pad(u, ((0, 0), (left, CONV_WIDTH - 1 - left), (0, 0)))
    out = b
    for j in range(CONV_WIDTH):
        out = out + up[:, j:j + T] * w[j]
    return out


def _rglru_coeffs(u, w_a, b_a, w_x, b_x, lam):
    B, T, W = u.shape
    ub = u.reshape(B, T, LRU_BLOCKS, LRU_BLOCK_DIM)
    r = jax.nn.sigmoid(jnp.einsum("btnd,nde->btne", ub, w_a).reshape(B, T, W) + b_a)
    i = jax.nn.sigmoid(jnp.einsum("btnd,nde->btne", ub, w_x).reshape(B, T, W) + b_x)
    log_a = -LRU_C * r.astype(jnp.float32) * jax.nn.softplus(-lam.astype(jnp.float32))
    a = jnp.exp(log_a)
    b = jnp.sqrt(-jnp.expm1(2.0 * log_a)) * (i * u).astype(jnp.float32)
    return a, b


def _linear_scan(a, b, h0):
    b = b.at[:, 0].add(a[:, 0] * h0)

    def combine(lhs, rhs):
        return lhs[0] * rhs[0], rhs[0] * lhs[1] + rhs[1]

    _, h = lax.associative_scan(combine, (a, b), axis=1)
    return h


def _rglru_bidirectional(u_ctx, u_lat, w_a, b_a, w_x, b_x, lam):
    B, _, W = u_ctx.shape
    hcs, hls = [], []
    for d in range(2):
        flip = (lambda t: t[:, ::-1]) if d == 1 else (lambda t: t)
        a_c, b_c = _rglru_coeffs(flip(u_ctx), w_a[d], b_a[d], w_x[d], b_x[d], lam[d])
        h_c = _linear_scan(a_c, b_c, jnp.zeros((B, W), jnp.float32))
        a_l, b_l = _rglru_coeffs(flip(u_lat), w_a[d], b_a[d], w_x[d], b_x[d], lam[d])
        h_l = _linear_scan(a_l, b_l, h_c[:, -1])
        hcs.append(flip(h_c))
        hls.append(flip(h_l))
    return hcs[0] + hcs[1], hls[0] + hls[1]


def _mixer(h, hc, row, col, need_ctx, w_in, q_lora_g, w_uq, kv_lora_g, w_ukv, q_norm_g, k_norm_g,
           conv_w, conv_b, w_rg_a, b_rg_a, w_rg_x, b_rg_x, lru_lambda, w_out):
    B, S, _ = h.shape
    C = hc.shape[1]
    splits = [Q_LORA_RANK, Q_LORA_RANK + KV_LORA_RANK, Q_LORA_RANK + KV_LORA_RANK + QK_ROPE_DIM,
              Q_LORA_RANK + KV_LORA_RANK + QK_ROPE_DIM + LRU_WIDTH]
    c_q, c_kv, k_r, u, g = jnp.split(h @ w_in, splits, axis=-1)
    cc_q, cc_kv, ck_r, cu, cg = jnp.split(hc @ w_in, splits, axis=-1)

    q = _axial_rope(_mla_q(c_q, q_lora_g, w_uq, q_norm_g), row, col)
    k, v = _mla_kv(c_kv, k_r, kv_lora_g, w_ukv, k_norm_g)
    k = _axial_rope(k, row, col)
    kc, vc = _mla_kv(cc_kv, ck_r, kv_lora_g, w_ukv, k_norm_g)
    o = _latent_attention(q, jnp.concatenate([kc, k], axis=1), jnp.concatenate([vc, v], axis=1))

    u_lat = _dwconv(u, conv_w, conv_b)
    u_ctx = _dwconv(cu, conv_w, conv_b)
    hr_ctx, hr_lat = _rglru_bidirectional(u_ctx, u_lat, w_rg_a, b_rg_a, w_rg_x, b_rg_x, lru_lambda)

    y = jnp.concatenate([o.reshape(B, S, ATTN_WIDTH),
                         jax.nn.gelu(g) * hr_lat.astype(h.dtype)], axis=-1) @ w_out
    if not need_ctx:
        return y, None
    qc = _mla_q(cc_q, q_lora_g, w_uq, q_norm_g)
    oc = _attend(qc, kc, vc)
    yc = jnp.concatenate([oc.reshape(B, C, ATTN_WIDTH),
                          jax.nn.gelu(cg) * hr_ctx.astype(hc.dtype)], axis=-1) @ w_out
    return y, yc


def _swiglu(h, w_ffn_in, w_ffn_out):
    gate, up = jnp.split(h @ w_ffn_in, [D_FF], axis=-1)
    return (jax.nn.silu(gate) * up) @ w_ffn_out


def setup_inputs(seed: int = 0) -> dict:
    key = jax.random.key(seed)
    ks = jax.random.split(key, 32)
    L = DEPTH

    def nrm(k, shape, fan_in, scale=1.0):
        return jax.random.normal(k, shape, jnp.float32) * (scale * fan_in ** -0.5)

    def gain(k, shape):
        return 1.0 + 0.02 * jax.random.normal(k, shape, jnp.float32)

    def bias(k, shape):
        return 0.01 * jax.random.normal(k, shape, jnp.float32)

    a0 = jax.random.uniform(ks[24], (L, 2, LRU_WIDTH), jnp.float32, 0.9, 0.999) ** (1.0 / LRU_C)
    lru_lambda = jnp.log(a0) - jnp.log1p(-a0)
    return {
        "x": jax.random.normal(ks[0], (BATCH, SEQ, D_MODEL), jnp.float32),
        "c": jax.random.normal(ks[1], (BATCH, D_MODEL), jnp.float32),
        "ctx": jax.random.normal(ks[2], (BATCH, CTX_LEN, D_MODEL), jnp.float32),
        "c_ctx": jax.random.normal(ks[3], (D_MODEL,), jnp.float32),
        "w_ada": nrm(ks[4], (L, D_MODEL, N_MOD * D_MODEL), D_MODEL, 0.5),
        "b_ada": bias(ks[5], (L, N_MOD * D_MODEL)),
        "norm_mix_g": gain(ks[6], (L, D_MODEL)),
        "norm_ffn_g": gain(ks[7], (L, D_MODEL)),
        "w_in": nrm(ks[8], (L, D_MODEL, IN_DIM), D_MODEL),
        "q_lora_g": gain(ks[9], (L, Q_LORA_RANK)),
        "w_uq": nrm(ks[10], (L, Q_LORA_RANK, N_HEADS * QK_DIM), Q_LORA_RANK),
        "kv_lora_g": gain(ks[11], (L, KV_LORA_RANK)),
        "w_ukv": nrm(ks[12], (L, KV_LORA_RANK, N_HEADS * (QK_NOPE_DIM + V_DIM)), KV_LORA_RANK),
        "q_norm_g": gain(ks[13], (L, QK_DIM)),
        "k_norm_g": gain(ks[14], (L, QK_DIM)),
        "conv_w": nrm(ks[15], (L, CONV_WIDTH, LRU_WIDTH), CONV_WIDTH),
        "conv_b": bias(ks[16], (L, LRU_WIDTH)),
        "w_rg_a": nrm(ks[17], (L, 2, LRU_BLOCKS, LRU_BLOCK_DIM, LRU_BLOCK_DIM), LRU_BLOCK_DIM),
        "b_rg_a": bias(ks[18], (L, 2, LRU_WIDTH)),
        "w_rg_x": nrm(ks[19], (L, 2, LRU_BLOCKS, LRU_BLOCK_DIM, LRU_BLOCK_DIM), LRU_BLOCK_DIM),
        "b_rg_x": bias(ks[20], (L, 2, LRU_WIDTH)),
        "lru_lambda": lru_lambda,
        "w_out": nrm(ks[21], (L, D_MODEL, D_MODEL), D_MODEL),
        "w_ffn_in": nrm(ks[22], (L, D_MODEL, 2 * D_FF), D_MODEL),
        "w_ffn_out": nrm(ks[23], (L, D_FF, D_MODEL), D_FF),
    }


def reference(x, c, ctx, c_ctx, w_ada, b_ada, norm_mix_g, norm_ffn_g, w_in, q_lora_g, w_uq,
              kv_lora_g, w_ukv, q_norm_g, k_norm_g, conv_w, conv_b, w_rg_a, b_rg_a, w_rg_x,
              b_rg_x, lru_lambda, w_out, w_ffn_in, w_ffn_out):
    S = x.shape[1]
    ROWS = S // GRID_W
    row = jnp.repeat(jnp.arange(ROWS, dtype=jnp.int32), GRID_W)
    col = jnp.tile(jnp.arange(GRID_W, dtype=jnp.int32), ROWS)
    s_c = jax.nn.silu(c)
    s_cc = jax.nn.silu(c_ctx)
    xc = ctx
    for l in range(DEPTH):
        need_ctx = l < DEPTH - 1
        mod = (s_c @ w_ada[l] + b_ada[l])[:, None, :]
        sh1, sc1, g1, sh2, sc2, g2 = jnp.split(mod, N_MOD, axis=-1)
        mod_c = s_cc @ w_ada[l] + b_ada[l]
        csh1, csc1, cg1, csh2, csc2, cg2 = jnp.split(mod_c, N_MOD, axis=-1)

        h = _modulate(_rmsnorm(x, norm_mix_g[l]), sh1, sc1)
        hc = _modulate(_rmsnorm(xc, norm_mix_g[l]), csh1, csc1)
        y, yc = _mixer(h, hc, row, col, need_ctx, w_in[l], q_lora_g[l], w_uq[l], kv_lora_g[l],
                       w_ukv[l], q_norm_g[l], k_norm_g[l], conv_w[l], conv_b[l], w_rg_a[l],
                       b_rg_a[l], w_rg_x[l], b_rg_x[l], lru_lambda[l], w_out[l])
        x = x + g1 * y
        h = _modulate(_rmsnorm(x, norm_ffn_g[l]), sh2, sc2)
        x = x + g2 * _swiglu(h, w_ffn_in[l], w_ffn_out[l])
        if need_ctx:
            xc = xc + cg1 * yc
            hc = _modulate(_rmsnorm(xc, norm_ffn_g[l]), csh2, csc2)
            xc = xc + cg2 * _swiglu(hc, w_ffn_in[l], w_ffn_out[l])
    return x
```

```cpp
#include <hip/hip_runtime.h>
#include <hip/hip_cooperative_groups.h>
#include <cstdio>
#include <cstdint>
#include <utility>
namespace cg = cooperative_groups;

#ifndef MK_MULTI_LAUNCH
#define MK_MULTI_LAUNCH 0
#endif

#define LAS __attribute__((address_space(3)))
typedef unsigned short bf16_t;
typedef short bf16x8 __attribute__((ext_vector_type(8)));
typedef float f32x4 __attribute__((ext_vector_type(4)));
typedef float f32x16 __attribute__((ext_vector_type(16)));
typedef unsigned u32x4 __attribute__((ext_vector_type(4)));
typedef unsigned u32x2 __attribute__((ext_vector_type(2)));
typedef _Float16 h16x2 __attribute__((ext_vector_type(2)));

constexpr int DM = 1024, NB = 16, SEQ = 2048, CTX = 256, TPB = SEQ + CTX, T = NB * TPB, DEPTH = 4;
constexpr int NH = 8, DQK = 96, QR = 384, KVR = 256, LRU = 512, DFF = 2816, IN_DIM = 1696, IN_PAD = 1792, NMOD = 6 * DM;
constexpr int TLAT = NB * SEQ;
constexpr int NCHUNK = TPB / 64;
constexpr float EPS = 1e-6f;
constexpr float QSCALE = 0.10206207261596577f * 1.4426950408889634f;

constexpr size_t MiB = 1u << 20;
constexpr size_t WS_MOD = 0, WS_SP = 1835008, WS_BAR = 1900544, BAR_BYTES = 16384;
constexpr size_t WS_WT = 2 * MiB;
constexpr size_t WT_IN = 0, WT_UQ = WT_IN + (size_t)IN_PAD * 1024 * 2, WT_KN = WT_UQ + (size_t)768 * 384 * 2, WT_VT = WT_KN + (size_t)512 * 256 * 2,
                 WT_G0 = WT_VT + (size_t)512 * 256 * 2, WT_G1 = WT_G0 + (size_t)1024 * 256 * 2, WT_OUT = WT_G1 + (size_t)1024 * 256 * 2,
                 WT_FFI = WT_OUT + (size_t)1024 * 1024 * 2, WT_FFO = WT_FFI + (size_t)5632 * 1024 * 2, WT_END = WT_FFO + (size_t)1024 * 2816 * 2;
static_assert(WT_END <= 26 * MiB, "weights region");
constexpr size_t WS_FFO_ALT = 28 * MiB;
constexpr size_t WS_RSS = 36 * MiB, WS_RSTD = 40 * MiB;
constexpr size_t WS_XR = 44 * MiB,
                  WS_SUMS = 116 * MiB, WS_G = 121 * MiB, WS_KR = 157 * MiB, WS_UC = 160 * MiB,
                 WS_Q = 196 * MiB, WS_K = 250 * MiB, WS_VT = 304 * MiB, WS_AB = 340 * MiB, WS_U = 340 * MiB, WS_CQ = 376 * MiB, WS_CKV = 403 * MiB,
                 WS_FF = 121 * MiB, WS_END = 484 * MiB;
static_assert(WS_FF + (size_t)T * DFF * 2 <= WS_AB + (size_t)T * 2 * 512 * 4, "ff overlay");
static_assert(WS_AB + (size_t)T * 2 * 512 * 4 <= WS_END, "ab");

constexpr int LDS_BYTES = 131072 + 8192, LDS_BARST = 131072 + 4096;

struct Args { const float* in[25]; float* out; unsigned char* ws; int ph_lo, ph_hi; };

__device__ __forceinline__ unsigned cvt_pk_bf16(float lo, float hi) { unsigned r; asm volatile("v_cvt_pk_bf16_f32 %0, %1, %2" : "=v"(r) : "v"(lo), "v"(hi)); return r; }
__device__ __forceinline__ float bf_lo(unsigned u) { return __uint_as_float(u << 16); }
__device__ __forceinline__ float bf_hi(unsigned u) { return __uint_as_float(u & 0xffff0000u); }
__device__ __forceinline__ float bf1(bf16_t u) { return __uint_as_float((unsigned)u << 16); }
__device__ __forceinline__ bf16_t f2bf(float f) { return (bf16_t)(cvt_pk_bf16(f, 0.f) & 0xffffu); }
__device__ __forceinline__ float wave_sum(float v) {
#pragma unroll
    for (int o = 1; o < 64; o <<= 1) v += __shfl_xor(v, o);
    return v;
}
__device__ __forceinline__ float sigmoidf_(float x) { return __builtin_amdgcn_rcpf(1.0f + __expf(-x)); }
__device__ __forceinline__ float gelu_tanh(float x) { const float u = 0.7978845608028654f * (x + 0.044715f * x * x * x); return x * __builtin_amdgcn_rcpf(1.0f + __expf(-2.0f * u)); }
__device__ __forceinline__ unsigned pack_h2(float a, float b) { h16x2 h; h.x = (_Float16)a; h.y = (_Float16)b; return __builtin_bit_cast(unsigned, h); }

namespace pg8 {
constexpr int BM = 256, BK = 64, HALF = 128, HTB = HALF * BK * 2, STAGE_BYTES = 8 * HTB, NXCD = 8, WGM = 8;
__host__ __device__ __forceinline__ int lds_byte(int r, int c) { const int st = (r >> 4) * 2 + (c >> 5), rr = r & 15, cc = c & 31, ob = rr * 64 + cc * 2; return st * 1024 + (ob ^ (((ob >> 9) & 1) << 5)); }
__host__ __device__ __forceinline__ void stage_rc(int b, int& R, int& C) { const int st = b / 1024, sb = b % 1024, swz = sb ^ (((sb >> 9) & 1) << 5); R = (st >> 1) * 16 + swz / 64; C = (st & 1) * 32 + (swz % 64) / 2; }
__host__ __device__ __forceinline__ int perm32(int rho) { const int n = rho >> 4, i = rho & 15; return 8 * (i >> 2) + 4 * n + (i & 3); }

struct Unit { int pm, pn; };
struct Gemm { const bf16_t* A; const bf16_t* Bt; int M, N, K, lda, ldb; };

struct StaticOrder {
    int nM, nN, nwg, G, c, lat_only;
    __device__ void init(int M, int N, int G_, int c_, int lat_only_ = 0) { nM = M / BM; nN = N / BM; nwg = nM * nN; G = G_; c = c_; lat_only = lat_only_; }
    __device__ bool next(int i, Unit& u) const {
        const long L = (long)i * G + c; if (L >= nwg) return false;
        int wgid = (int)L; { const int q = nwg / NXCD, r = nwg % NXCD, xcd = wgid % NXCD, off = wgid / NXCD; wgid = (xcd < r ? xcd * (q + 1) : r * (q + 1) + (xcd - r) * q) + off; }
        const int nig = WGM * nN, gid = wgid / nig, fm = gid * WGM, gsz = (nM - fm) < WGM ? (nM - fm) : WGM;
        u.pm = fm + ((wgid % nig) % gsz); u.pn = (wgid % nig) / gsz; if (lat_only) u.pm = (u.pm >> 3) * 9 + 1 + (u.pm & 7); return true;
    }
};

template <class Epi, bool ALIGN_EPI>
__device__ __forceinline__ void gemm_phase(LAS unsigned char* lds, const Gemm g, const StaticOrder& S, const Epi& E, const int tid_in) {
    int tid = tid_in; asm volatile("" : "+v"(tid));
    const int wid = __builtin_amdgcn_readfirstlane(tid >> 6), lane = tid & 63, wr = wid >> 2, wc = wid & 3, fr = lane & 15, fq = lane >> 4;
    const int K = g.K, nt = K / BK;
    unsigned voffA[2], voffB[2];
#pragma unroll
    for (int i = 0; i < 2; ++i) { int R, C; stage_rc(tid * 16 + i * 8192, R, C); const int Rb = Epi::PERM ? ((R & ~31) + perm32(R & 31)) : R;
        voffA[i] = (unsigned)(R * g.lda + C) * 2u; voffB[i] = (unsigned)(Rb * g.ldb + C) * 2u;
        asm volatile("" : "+v"(voffA[i])); asm volatile("" : "+v"(voffB[i])); }
    const size_t kstep = (size_t)(BK * 2);
    const size_t hstepA = (size_t)HALF * g.lda * 2, hstepB = (size_t)HALF * g.ldb * 2;
    const size_t tstepA = 2 * hstepA, tstepB = 2 * hstepB;
    const unsigned ldsw = (unsigned)wid * 1024u;
    const int aoff = lds_byte(wr * 64 + fr, fq * 8), boff = lds_byte(wc * 32 + fr, fq * 8);
#define PG8_SA(b, h) (((b) * 2 + (h)) * HTB)
#define PG8_SB(b, h) ((4 + (b) * 2 + (h)) * HTB)
#define PG8_STAGE(bufoff, gbase, voff) do { const char* _gb = (const char*)(gbase); asm volatile("" : "+s"(_gb)); _Pragma("unroll") for (int _i = 0; _i < 2; ++_i) \
        __builtin_amdgcn_global_load_lds((const unsigned*)(_gb + (voff)[_i]), (LAS unsigned*)(lds + (bufoff) + ldsw + _i * 8192), 16, 0, 0); } while (0)
#define PG8_LDA(dst, b, h) do { _Pragma("unroll") for (int m = 0; m < 4; ++m) _Pragma("unroll") for (int k = 0; k < 2; ++k) dst[m][k] = *(const LAS bf16x8*)(lds + PG8_SA(b, h) + aoff + m * 2048 + k * 1024); } while (0)
#define PG8_LDB(dst, b, h) do { _Pragma("unroll") for (int n = 0; n < 2; ++n) _Pragma("unroll") for (int k = 0; k < 2; ++k) dst[n][k] = *(const LAS bf16x8*)(lds + PG8_SB(b, h) + boff + n * 2048 + k * 1024); } while (0)
#define PG8_MMA(ai, bj, At, Bt) do { __builtin_amdgcn_s_setprio(1); _Pragma("unroll") for (int m = 0; m < 4; ++m) _Pragma("unroll") for (int n = 0; n < 2; ++n) _Pragma("unroll") for (int k = 0; k < 2; ++k) \
        acc[ai][bj][m][n] = __builtin_amdgcn_mfma_f32_16x16x32_bf16(Bt[n][k], At[m][k], acc[ai][bj][m][n], 0, 0, 0); __builtin_amdgcn_s_setprio(0); } while (0)
#define PG8_WAIT_V(n) asm volatile("s_waitcnt vmcnt(" #n ")" ::: "memory")
#define PG8_WAIT_L(n) asm volatile("s_waitcnt lgkmcnt(" #n ")" ::: "memory")
#define PG8_BAR __builtin_amdgcn_s_barrier()
#define PG8_SCHED __builtin_amdgcn_sched_barrier(0)
    Unit cur, nxt; int ui = 0;
    if (!S.next(0, cur)) return;
    f32x4 acc[2][2][4][2];
#pragma unroll
    for (int a = 0; a < 2; ++a)
#pragma unroll
        for (int b = 0; b < 2; ++b)
#pragma unroll
            for (int m = 0; m < 4; ++m)
#pragma unroll
                for (int n = 0; n < 2; ++n) acc[a][b][m][n] = (f32x4){0.f, 0.f, 0.f, 0.f};
    bf16x8 At[4][2], B0[2][2], B1[2][2];
    const char* cA = (const char*)g.A + (size_t)cur.pm * tstepA; const char* cB = (const char*)g.Bt + (size_t)cur.pn * tstepB;
    PG8_STAGE(PG8_SB(0, 0), cB, voffB); PG8_STAGE(PG8_SB(0, 1), cB + hstepB, voffB); PG8_STAGE(PG8_SA(0, 0), cA, voffA); PG8_STAGE(PG8_SA(0, 1), cA + hstepA, voffA);
    if (wr == 1) PG8_BAR;
    PG8_WAIT_V(2); PG8_BAR;
    PG8_STAGE(PG8_SB(1, 0), cB + kstep, voffB); PG8_STAGE(PG8_SA(1, 0), cA + kstep, voffA); PG8_STAGE(PG8_SB(1, 1), cB + hstepB + kstep, voffB);
    PG8_WAIT_V(6); PG8_BAR;
    for (;;) {
        const bool has_next = S.next(ui + 1, nxt);
        const char* nA = has_next ? (const char*)g.A + (size_t)nxt.pm * tstepA : cA; const char* nB = has_next ? (const char*)g.Bt + (size_t)nxt.pn * tstepB : cB;
        for (int t = 0; t < nt; t += 2) {
            const bool last = (t == nt - 2);
            const char* a1 = cA + (size_t)(t + 1) * kstep;
            const char* a2 = last ? nA : cA + (size_t)(t + 2) * kstep; const char* b2 = last ? nB : cB + (size_t)(t + 2) * kstep;
            const char* a3 = a2 + kstep; const char* b3 = b2 + kstep;
            PG8_LDB(B0, 0, 0); PG8_LDB(B1, 0, 1); PG8_SCHED; PG8_LDA(At, 0, 0); PG8_STAGE(PG8_SA(1, 1), a1 + hstepA, voffA);
            PG8_WAIT_V(8); PG8_WAIT_L(0); PG8_BAR; PG8_MMA(0, 0, At, B0); PG8_MMA(0, 1, At, B1); PG8_BAR; PG8_SCHED;
            PG8_LDA(At, 0, 1); PG8_STAGE(PG8_SB(0, 0), b2, voffB); PG8_STAGE(PG8_SB(0, 1), b2 + hstepB, voffB); PG8_STAGE(PG8_SA(0, 0), a2, voffA);
            PG8_WAIT_V(8); PG8_WAIT_L(0); PG8_BAR; PG8_MMA(1, 0, At, B0); PG8_MMA(1, 1, At, B1); PG8_BAR; PG8_SCHED;
            PG8_LDB(B0, 1, 0); PG8_LDB(B1, 1, 1); PG8_SCHED; PG8_LDA(At, 1, 0); PG8_STAGE(PG8_SA(0, 1), a2 + hstepA, voffA);
            PG8_WAIT_V(8); PG8_WAIT_L(0); PG8_BAR; PG8_MMA(0, 0, At, B0); PG8_MMA(0, 1, At, B1); PG8_BAR; PG8_SCHED;
            PG8_LDA(At, 1, 1); PG8_STAGE(PG8_SB(1, 0), b3, voffB); PG8_STAGE(PG8_SB(1, 1), b3 + hstepB, voffB); PG8_STAGE(PG8_SA(1, 0), a3, voffA);
            PG8_WAIT_V(8); PG8_WAIT_L(0); PG8_BAR; PG8_MMA(1, 0, At, B0); PG8_MMA(1, 1, At, B1); PG8_BAR; PG8_SCHED;
        }
        if constexpr (ALIGN_EPI) { if (wr == 0) PG8_BAR; }
        PG8_SCHED; { int l2; asm volatile("v_mbcnt_lo_u32_b32 %0, -1, 0\n\tv_mbcnt_hi_u32_b32 %0, -1, %0" : "=v"(l2));
          E(acc, cur, wr, wc, l2 & 15, l2 >> 4); } PG8_SCHED;
        if (!has_next) break;
#pragma unroll
        for (int a = 0; a < 2; ++a)
#pragma unroll
            for (int b = 0; b < 2; ++b)
#pragma unroll
                for (int m = 0; m < 4; ++m)
#pragma unroll
                    for (int n = 0; n < 2; ++n) acc[a][b][m][n] = (f32x4){0.f, 0.f, 0.f, 0.f};
        cur = nxt; cA = nA; cB = nB; ++ui;
        if constexpr (ALIGN_EPI) { if (wr == 1) PG8_BAR; }
    }
    PG8_WAIT_V(0);
    if constexpr (!ALIGN_EPI) { if (wr == 0) PG8_BAR; }
    PG8_BAR;
#undef PG8_SA
#undef PG8_SB
#undef PG8_STAGE
#undef PG8_LDA
#undef PG8_LDB
#undef PG8_MMA
#undef PG8_WAIT_V
#undef PG8_WAIT_L
#undef PG8_BAR
#undef PG8_SCHED
}

template <int MODE> struct EpiStore {
    static constexpr bool PERM = true;
    bf16_t* O; int ldc; bf16_t *cq, *ckv, *kr, *u, *g;
    float* rss;
    const float* rs; float inv_n; int colscale;
    __device__ __forceinline__ void operator()(const f32x4 (&acc)[2][2][4][2], const Unit& un, int wr, int wc, int fr, int fq) const {
        const int row0 = un.pm * BM + wr * 64 + fr;
        if (MODE != 1) {
            int c0 = un.pn * BM + wc * 32 + 8 * fq;
            asm volatile("" : "+v"(c0));
            const int pitch = (MODE == 0) ? ldc : 768;
            bf16_t* p = (MODE == 0) ? O + c0 : O + (c0 >> 6) * 96 + (c0 & 63);
            const int bjstep = (MODE == 0) ? HALF : 192;
            f32x4 csc[2][2];
#pragma unroll
            for (int bj = 0; bj < 2; ++bj)
#pragma unroll
                for (int n = 0; n < 2; ++n) { csc[bj][n] = (f32x4){1.f, 1.f, 1.f, 1.f};
                    if (MODE == 0 && colscale) csc[bj][n] = *(const f32x4*)(rs + c0 + bj * HALF + 4 * n); }
            float rrows[2][4];
#pragma unroll
            for (int ai = 0; ai < 2; ++ai)
#pragma unroll
                for (int m = 0; m < 4; ++m) rrows[ai][m] = (rs != nullptr && !colscale) ? rs[row0 + ai * HALF + m * 16] : 1.0f;
#pragma unroll
            for (int ai = 0; ai < 2; ++ai)
#pragma unroll
                for (int m = 0; m < 4; ++m) {
                    bf16_t* rp = p + (size_t)(row0 + ai * HALF + m * 16) * pitch;
                    const float rrow = rrows[ai][m];
#pragma unroll
                    for (int bj = 0; bj < 2; ++bj) {
                        f32x4 v0 = acc[ai][bj][m][0] * rrow, v1 = acc[ai][bj][m][1] * rrow;
                        if (colscale) { v0 = v0 * csc[bj][0]; v1 = v1 * csc[bj][1]; }
                        u32x4 w; w.x = cvt_pk_bf16(v0[0], v0[1]); w.y = cvt_pk_bf16(v0[2], v0[3]); w.z = cvt_pk_bf16(v1[0], v1[1]); w.w = cvt_pk_bf16(v1[2], v1[3]);
                        *(u32x4*)(rp + bj * bjstep) = w;
                    }
                    asm volatile("" ::: "memory");
                }
            return;
        }
#pragma unroll
        for (int bj = 0; bj < 2; ++bj) {
            const int c0 = un.pn * BM + bj * HALF + wc * 32 + 8 * fq;
            bf16_t* p; int pitch;
            if (c0 < 384) { p = cq + c0; pitch = 384; }
            else if (c0 < 640) { p = ckv + (c0 - 384); pitch = 256; }
            else if (c0 < 672) { p = kr + (c0 - 640); pitch = 32; }
            else if (c0 < 1184) { p = u + (c0 - 672); pitch = 512; }
            else if (c0 < 1696) { p = g + (c0 - 1184); pitch = 512; }
            else { p = nullptr; pitch = 0; }
            if (p == nullptr) continue;
            const int grp = (c0 < 640) ? (c0 >> 5) : -1;
#pragma unroll
            for (int ai = 0; ai < 2; ++ai)
#pragma unroll
                for (int m = 0; m < 4; ++m) {
                    const f32x4 v0 = acc[ai][bj][m][0], v1 = acc[ai][bj][m][1];
                    u32x4 w; w.x = cvt_pk_bf16(v0[0], v0[1]); w.y = cvt_pk_bf16(v0[2], v0[3]); w.z = cvt_pk_bf16(v1[0], v1[1]); w.w = cvt_pk_bf16(v1[2], v1[3]);
                    *(u32x4*)(p + (size_t)(row0 + ai * HALF + m * 16) * pitch) = w;
                    if (grp >= 0) {
                        float sq = (v0[0] * v0[0] + v0[1] * v0[1]) + (v0[2] * v0[2] + v0[3] * v0[3]) + (v1[0] * v1[0] + v1[1] * v1[1]) + (v1[2] * v1[2] + v1[3] * v1[3]);
                        sq += __shfl_xor(sq, 16); sq += __shfl_xor(sq, 32);
                        if (fq == 0) rss[(size_t)(row0 + ai * HALF + m * 16) * 20 + grp] = sq;
                    }
                }
        }
    }
};
struct EpiGates {
    static constexpr bool PERM = false;
    const float *ba, *bx, *sp8;
    const bf16_t* uc; unsigned* ab;
    __device__ __forceinline__ void load_u(const Unit& un, int wr, int wc, int fr, int fq, u32x2 (&uu)[2][4]) const {
        const int row0 = un.pm * BM + wr * 64 + fr, ch = 64 * un.pn + 16 * wc + 4 * fq;
#pragma unroll
        for (int ai = 0; ai < 2; ++ai)
#pragma unroll
            for (int m = 0; m < 4; ++m) uu[ai][m] = *(const u32x2*)(uc + (size_t)(row0 + ai * HALF + m * 16) * 512 + ch);
    }
    __device__ __forceinline__ void operator()(const f32x4 (&acc)[2][2][4][2], const Unit& un, int wr, int wc, int fr, int fq, const u32x2 (&uu)[2][4]) const {
        const int row0 = un.pm * BM + wr * 64 + fr, ch = 64 * un.pn + 16 * wc + 4 * fq;
        f32x4 ba4_[2], bx4_[2], sp_[2];
#pragma unroll
        for (int d = 0; d < 2; ++d) { ba4_[d] = *(const f32x4*)(ba + d * 512 + ch); bx4_[d] = *(const f32x4*)(bx + d * 512 + ch); sp_[d] = *(const f32x4*)(sp8 + d * 512 + ch); }
#pragma unroll
        for (int bj = 0; bj < 2; ++bj) {
            const int d = bj;
            const f32x4 ba4 = ba4_[d], bx4 = bx4_[d], sp = sp_[d];
#pragma unroll
            for (int ai = 0; ai < 2; ++ai)
#pragma unroll
                for (int m = 0; m < 4; ++m) {
                    const int row = row0 + ai * HALF + m * 16;
                    const float uv[4] = {bf_lo(uu[ai][m].x), bf_hi(uu[ai][m].x), bf_lo(uu[ai][m].y), bf_hi(uu[ai][m].y)};
                    unsigned w[4];
#pragma unroll
                    for (int e = 0; e < 4; ++e) {
                        const float r = sigmoidf_(acc[ai][bj][m][0][e] + ba4[e]), ig = sigmoidf_(acc[ai][bj][m][1][e] + bx4[e]);
                        const float la = -r * sp[e];
                        const float bb = __builtin_amdgcn_sqrtf(fmaxf(1.0f - __expf(2.0f * la), 0.f)) * (ig * uv[e]);
                        w[e] = pack_h2(la, bb);
                    }
                    *(u32x4*)(ab + ((size_t)row * 2 + d) * 512 + ch) = (u32x4){w[0], w[1], w[2], w[3]};
                }
        }
    }
};
template <bool FINAL> struct EpiResid {
    static constexpr bool PERM = true;
    const float* gate;
    bf16_t* xr; float* out;
    __device__ __forceinline__ void operator()(const f32x4 (&acc)[2][2][4][2], const Unit& un, int wr, int wc, int fr, int fq) const {
        const int b = un.pm / 9, jj = un.pm % 9;
        const float* gp = gate + (size_t)(jj == 0 ? 16 : b) * NMOD;
        const int row0 = un.pm * BM + wr * 64 + fr, col0 = un.pn * BM + wc * 32 + 8 * fq;
        f32x4 g4[2][2];
#pragma unroll
        for (int bj = 0; bj < 2; ++bj)
#pragma unroll
            for (int n = 0; n < 2; ++n) g4[bj][n] = *(const f32x4*)(gp + col0 + bj * HALF + n * 4);
        u32x4 xin[2][4][2];
#pragma unroll
        for (int ai = 0; ai < 2; ++ai)
#pragma unroll
            for (int m = 0; m < 4; ++m)
#pragma unroll
                for (int bj = 0; bj < 2; ++bj) xin[ai][m][bj] = *(const u32x4*)(xr + (size_t)(row0 + ai * HALF + m * 16) * DM + col0 + bj * HALF);
#pragma unroll
        for (int ai = 0; ai < 2; ++ai) {
#pragma unroll
            for (int m = 0; m < 4; ++m) {
                const int row = row0 + ai * HALF + m * 16;
                bf16_t* xp = xr + (size_t)row * DM + col0;
#pragma unroll
                for (int bj = 0; bj < 2; ++bj) {
                    const u32x4 xi = xin[ai][m][bj];
                    const f32x4 x0 = (f32x4){bf_lo(xi.x), bf_hi(xi.x), bf_lo(xi.y), bf_hi(xi.y)}, x1 = (f32x4){bf_lo(xi.z), bf_hi(xi.z), bf_lo(xi.w), bf_hi(xi.w)};
                    const f32x4 y0 = x0 + g4[bj][0] * acc[ai][bj][m][0], y1 = x1 + g4[bj][1] * acc[ai][bj][m][1];
                    if (FINAL) {
                        float* op = out + ((size_t)b * SEQ + (size_t)(jj - 1) * 256 + (row - un.pm * BM)) * DM + col0 + bj * HALF;
                        *(f32x4*)op = y0; *(f32x4*)(op + 4) = y1;
                    } else {
                        u32x4 w; w.x = cvt_pk_bf16(y0[0], y0[1]); w.y = cvt_pk_bf16(y0[2], y0[3]); w.z = cvt_pk_bf16(y1[0], y1[1]); w.w = cvt_pk_bf16(y1[2], y1[3]);
                        *(u32x4*)(xp + bj * HALF) = w;
                    }
                }
            }
            asm volatile("" ::: "memory");
        }
    }
};
struct EpiSwiglu {
    static constexpr bool PERM = false;
    bf16_t* ff;
    __device__ __forceinline__ void operator()(const f32x4 (&acc)[2][2][4][2], const Unit& un, int wr, int wc, int fr, int fq) const {
        const int row0 = un.pm * BM + wr * 64 + fr;
#pragma unroll
        for (int bj = 0; bj < 2; ++bj) {
            const int j0 = (un.pn * 8 + bj * 4 + wc) * 16 + 4 * fq;
#pragma unroll
            for (int ai = 0; ai < 2; ++ai)
#pragma unroll
                for (int m = 0; m < 4; ++m) {
                    const f32x4 gt = acc[ai][bj][m][0], up = acc[ai][bj][m][1];
                    float v[4];
#pragma unroll
                    for (int e = 0; e < 4; ++e) v[e] = gt[e] * sigmoidf_(gt[e]) * up[e];
                    u32x2 w; w.x = cvt_pk_bf16(v[0], v[1]); w.y = cvt_pk_bf16(v[2], v[3]);
                    *(u32x2*)(ff + (size_t)(row0 + ai * HALF + m * 16) * DFF + j0) = w;
                }
        }
    }
};
}

__device__ __forceinline__ void gates_phase(LAS unsigned char* lds, const bf16_t* uc, const bf16_t* wg, const pg8::EpiGates& E, float* sums, const int tid_in, const int bid, const int G) {
    int tid = tid_in; asm volatile("" : "+v"(tid));
    const int wid = __builtin_amdgcn_readfirstlane(tid >> 6), lane = tid & 63, wr = wid >> 2, wc = wid & 3, fr = lane & 15, fq = lane >> 4;
    constexpr int P = 144, NU = (T / 256) * 8;
    LAS unsigned char* As = lds; LAS unsigned char* Bs = lds + 256 * P;
    const int lrow = tid >> 3, c8 = tid & 7;
    u32x4 ra[4], rb[4];
    int unit = bid;
    if (unit < NU) {
        const int pm = unit >> 3, nb = unit & 7;
#pragma unroll
        for (int i = 0; i < 4; ++i) { ra[i] = *(const u32x4*)(uc + (size_t)(pm * 256 + 64 * i + lrow) * LRU + 64 * nb + 8 * c8); rb[i] = *(const u32x4*)(wg + (size_t)(nb * 256 + 64 * i + lrow) * 64 + 8 * c8); }
    }
    while (unit < NU) {
        const int pm = unit >> 3, nb = unit & 7;
#pragma unroll
        for (int i = 0; i < 4; ++i) { *(LAS u32x4*)(As + (64 * i + lrow) * P + 16 * c8) = ra[i]; *(LAS u32x4*)(Bs + (64 * i + lrow) * P + 16 * c8) = rb[i]; }
        __syncthreads();
        const int nxt = unit + G;
        if (nxt < NU) {
            const int pm2 = nxt >> 3, nb2 = nxt & 7;
#pragma unroll
            for (int i = 0; i < 4; ++i) { ra[i] = *(const u32x4*)(uc + (size_t)(pm2 * 256 + 64 * i + lrow) * LRU + 64 * nb2 + 8 * c8); rb[i] = *(const u32x4*)(wg + (size_t)(nb2 * 256 + 64 * i + lrow) * 64 + 8 * c8); }
        }
        const pg8::Unit un{pm, nb};
        u32x2 uu[2][4]; E.load_u(un, wr, wc, fr, fq, uu);
        f32x4 acc[2][2][4][2];
#pragma unroll
        for (int ai = 0; ai < 2; ++ai) {
            bf16x8 At[4][2];
#pragma unroll
            for (int m = 0; m < 4; ++m)
#pragma unroll
                for (int k = 0; k < 2; ++k) At[m][k] = *(const LAS bf16x8*)(As + (128 * ai + 64 * wr + 16 * m + fr) * P + 64 * k + 16 * fq);
#pragma unroll
            for (int bj = 0; bj < 2; ++bj) {
                bf16x8 Bf[2][2];
#pragma unroll
                for (int n = 0; n < 2; ++n)
#pragma unroll
                    for (int k = 0; k < 2; ++k) Bf[n][k] = *(const LAS bf16x8*)(Bs + (128 * bj + 32 * wc + 16 * n + fr) * P + 64 * k + 16 * fq);
#pragma unroll
                for (int m = 0; m < 4; ++m)
#pragma unroll
                    for (int n = 0; n < 2; ++n) {
                        f32x4 c = (f32x4){0.f, 0.f, 0.f, 0.f};
#pragma unroll
                        for (int k = 0; k < 2; ++k) c = __builtin_amdgcn_mfma_f32_16x16x32_bf16(Bf[n][k], At[m][k], c, 0, 0, 0);
                        acc[ai][bj][m][n] = c;
                    }
            }
        }
        __syncthreads();
        E(acc, un, wr, wc, fr, fq, uu);
        asm volatile("s_waitcnt vmcnt(0)" ::: "memory"); __syncthreads();
        {
            const int cl = wid >> 1, d = wid & 1, ch = 64 * nb + lane, t0 = pm * 256 + cl * 64;
            const unsigned* abp = E.ab + ((size_t)t0 * 2 + d) * 512 + ch;
            float hs = 0.f, sl = 0.f;
            unsigned av[64];
#pragma unroll
            for (int i = 0; i < 64; ++i) av[i] = abp[(size_t)i * 1024];
            if (d == 0) {
#pragma unroll
                for (int i = 0; i < 64; ++i) { const h16x2 v = __builtin_bit_cast(h16x2, av[i]); const float la = (float)v.x; hs = __expf(la) * hs + (float)v.y; sl += la; }
            } else {
#pragma unroll
                for (int i = 63; i >= 0; --i) { const h16x2 v = __builtin_bit_cast(h16x2, av[i]); const float la = (float)v.x; hs = __expf(la) * hs + (float)v.y; sl += la; }
            }
            const int bc = (pm / 9) * NCHUNK + (pm % 9) * 4 + cl;
            *(float2*)(sums + (((size_t)bc * 2 + d) * 512 + ch) * 2) = make_float2(sl, hs);
        }
        unit = nxt;
    }
}

struct WSrc { const float* p; int ld, klo, khi; const float* kg; };
__device__ __forceinline__ WSrc wsrc(const Args& a, int l, int mat, int n) {
    WSrc s; s.p = nullptr; s.ld = 0; s.klo = 0; s.khi = 1 << 30; s.kg = nullptr;
    switch (mat) {
        case 0: if (n < IN_DIM) { s.p = a.in[8] + (size_t)l * DM * IN_DIM + n; s.ld = IN_DIM; } break;
        case 1: s.p = a.in[10] + (size_t)l * QR * 768 + n; s.ld = 768; s.kg = a.in[9] + (size_t)l * QR; break;
        case 2: s.p = a.in[12] + (size_t)l * KVR * 1024 + (n >> 6) * 128 + (n & 63); s.ld = 1024; s.kg = a.in[11] + (size_t)l * KVR; break;
        case 3: s.p = a.in[12] + (size_t)l * KVR * 1024 + (n >> 6) * 128 + 64 + (n & 63); s.ld = 1024; s.kg = a.in[11] + (size_t)l * KVR; break;
        case 4: case 5: {
            const int nb = n >> 8, c = n & 255, d = c >> 7, chg = (c >> 5) & 3, kind = (c >> 4) & 1, c16 = c & 15, e = 16 * chg + c16;
            const float* w = kind ? a.in[19] : a.in[17];
            s.p = w + ((((size_t)l * 2 + d) * 8 + nb) * 64) * 64 + e; s.ld = 64; } break;
        case 6: s.p = a.in[22] + (size_t)l * DM * DM + n; s.ld = DM; break;
        case 7: { const int g32 = n >> 5, kind = (n >> 4) & 1, c16 = n & 15, jc = g32 * 16 + c16; s.p = a.in[23] + (size_t)l * DM * 2 * DFF + (kind ? DFF + jc : jc); s.ld = 2 * DFF; } break;
        default: s.p = a.in[24] + (size_t)l * DFF * DM + n; s.ld = DM; break;
    }
    return s;
}
__device__ __forceinline__ void wt_item(const Args& a, int l, int mat, int K, int N, bf16_t* WT, LAS float* scr, int item, int lane) {
    const int nblk = N / 32, kb = item / nblk, nb = item % nblk, k0 = 64 * kb, n0 = 32 * nb;
    const int n4 = (lane & 7) * 4, kr = lane >> 3;
    const WSrc s = wsrc(a, l, mat, n0 + n4);
    f32x4 v[8];
#pragma unroll
    for (int i = 0; i < 8; ++i) { const int k = k0 + 8 * i + kr;
        v[i] = (f32x4){0.f, 0.f, 0.f, 0.f}; if (s.p != nullptr && k >= s.klo && k < s.khi) { v[i] = *(const f32x4*)(s.p + (size_t)(k - s.klo) * s.ld); if (s.kg != nullptr) v[i] = v[i] * s.kg[k]; } }
#pragma unroll
    for (int i = 0; i < 8; ++i) { LAS float* d = scr + (8 * i + kr) * 33 + n4; d[0] = v[i][0]; d[1] = v[i][1]; d[2] = v[i][2]; d[3] = v[i][3]; }
    asm volatile("s_waitcnt lgkmcnt(0)" ::: "memory");
    const int c = lane & 7;
#pragma unroll
    for (int j = 0; j < 4; ++j) { const int n = (lane >> 3) + 8 * j; const LAS float* sp = scr + (8 * c) * 33 + n;
        u32x4 o; o.x = cvt_pk_bf16(sp[0 * 33], sp[1 * 33]); o.y = cvt_pk_bf16(sp[2 * 33], sp[3 * 33]); o.z = cvt_pk_bf16(sp[4 * 33], sp[5 * 33]); o.w = cvt_pk_bf16(sp[6 * 33], sp[7 * 33]);
        *(u32x4*)(WT + (size_t)(n0 + n) * K + k0 + 8 * c) = o; }
    asm volatile("s_waitcnt lgkmcnt(0)" ::: "memory");
}
__device__ __forceinline__ void convert_weights(const Args& a, int l, LAS unsigned char* lds, int gw, int NGW, int wid, int lane) {
    LAS float* scr = (LAS float*)(lds + wid * 8704);
    bf16_t* wt = (bf16_t*)(a.ws + WS_WT);
    const size_t ffo = (l & 1) ? (WS_FFO_ALT - WS_WT) : WT_FFO;
    const int Ks[9] = {1024, 384, 256, 256, 64, 64, 1024, 1024, 2816};
    const int Ns[9] = {IN_PAD, 768, 512, 512, 2048, 0, 1024, 5632, 1024};
    const size_t offs[9] = {WT_IN, WT_UQ, WT_KN, WT_VT, WT_G0, WT_G1, WT_OUT, WT_FFI, ffo};
#pragma unroll
    for (int mat = 0; mat < 9; ++mat) {
        const int K = Ks[mat], N = Ns[mat], items = (K / 64) * (N / 32);
        for (int it = gw; it < items; it += NGW) wt_item(a, l, mat, K, N, wt + offs[mat] / 2, scr, it, lane);
    }
}

__device__ __forceinline__ void mod_phase(const Args& a, LAS unsigned char* lds, const int tid, const int ubeg, const int uend, const int first, const int stride) {
    LAS float* s = (LAS float*)lds;
    LAS float* red = (LAS float*)(lds + 17 * 1024 * 4);
    for (int i = tid; i < 17 * 1024; i += 512) { const int r = i >> 10, k = i & 1023; const float v = r < 16 ? a.in[1][r * 1024 + k] : a.in[3][k]; s[i] = v * sigmoidf_(v); }
    __syncthreads();
    float* mod = (float*)(a.ws + WS_MOD);
    const int ks = tid >> 6, cl = tid & 63;
    for (int unit = ubeg + first; unit < uend; unit += stride) {
        const int l = unit / 96, n0 = (unit % 96) * 64;
        const float* w = a.in[4] + (size_t)l * DM * NMOD + n0 + cl;
        float acc[17];
#pragma unroll
        for (int r = 0; r < 17; ++r) acc[r] = 0.f;
        for (int kk = 0; kk < 128; kk += 8) {
            const int k = ks * 128 + kk;
            float wv[8];
#pragma unroll
            for (int j = 0; j < 8; ++j) wv[j] = w[(size_t)(k + j) * NMOD];
#pragma unroll
            for (int j4 = 0; j4 < 2; ++j4)
#pragma unroll
                for (int r = 0; r < 17; ++r) { const f32x4 sv = *(const LAS f32x4*)(s + r * 1024 + k + 4 * j4); acc[r] += sv[0] * wv[4 * j4] + sv[1] * wv[4 * j4 + 1] + sv[2] * wv[4 * j4 + 2] + sv[3] * wv[4 * j4 + 3]; }
        }
#pragma unroll
        for (int r = 0; r < 17; ++r) red[(ks * 17 + r) * 64 + cl] = acc[r];
        __syncthreads();
        for (int i = tid; i < 17 * 64; i += 512) { const int r = i >> 6, c = i & 63; float v = a.in[5][(size_t)l * NMOD + n0 + c];
#pragma unroll
            for (int q = 0; q < 8; ++q) v += red[(q * 17 + r) * 64 + c];
            mod[((size_t)l * 17 + r) * NMOD + n0 + c] = v; }
        __syncthreads();
    }
}

__device__ __forceinline__ void norm_rows(int t_begin, int t_end, const bf16_t* xr, const float* modl, int sh_off, int sc_off, const float* gain, bf16_t* H, int lane, float* rss_zero) {
    if (rss_zero != nullptr) { for (int t = t_begin + lane; t < t_end; t += 64) { rss_zero[t] = 0.f; rss_zero[T + t] = 0.f; } }
    f32x4 g[4];
#pragma unroll
    for (int q = 0; q < 4; ++q) g[q] = *(const f32x4*)(gain + 8 * lane + 512 * (q >> 1) + 4 * (q & 1));
    constexpr int NT = 3;
    for (int t0 = t_begin; t0 < t_end; t0 += NT) {
        u32x4 xi[NT][2]; f32x4 sh[NT][4], sc[NT][4];
#pragma unroll
        for (int r = 0; r < NT; ++r) {
            const int t = (t0 + r < t_end) ? t0 + r : t0;
            const int b = t / TPB, j = t % TPB;
            const float* mp = modl + (size_t)(j < CTX ? 16 : b) * NMOD;
#pragma unroll
            for (int q = 0; q < 2; ++q) xi[r][q] = *(const u32x4*)(xr + (size_t)t * DM + 8 * lane + 512 * q);
#pragma unroll
            for (int q = 0; q < 4; ++q) { const int k = 8 * lane + 512 * (q >> 1) + 4 * (q & 1); sh[r][q] = *(const f32x4*)(mp + sh_off + k); sc[r][q] = *(const f32x4*)(mp + sc_off + k); }
        }
#pragma unroll
        for (int r = 0; r < NT; ++r) {
            if (t0 + r >= t_end) break;
            f32x4 v[4];
#pragma unroll
            for (int q = 0; q < 2; ++q) { const u32x4 w = xi[r][q]; v[2 * q] = (f32x4){bf_lo(w.x), bf_hi(w.x), bf_lo(w.y), bf_hi(w.y)}; v[2 * q + 1] = (f32x4){bf_lo(w.z), bf_hi(w.z), bf_lo(w.w), bf_hi(w.w)}; }
            float ss = 0.f;
#pragma unroll
            for (int q = 0; q < 4; ++q) ss += v[q][0] * v[q][0] + v[q][1] * v[q][1] + v[q][2] * v[q][2] + v[q][3] * v[q][3];
            const float rstd = rsqrtf(wave_sum(ss) * (1.0f / DM) + EPS);
#pragma unroll
            for (int q = 0; q < 2; ++q) {
                const f32x4 y0 = (v[2 * q] * rstd * g[2 * q]) * (sc[r][2 * q] + 1.0f) + sh[r][2 * q], y1 = (v[2 * q + 1] * rstd * g[2 * q + 1]) * (sc[r][2 * q + 1] + 1.0f) + sh[r][2 * q + 1];
                u32x4 w; w.x = cvt_pk_bf16(y0[0], y0[1]); w.y = cvt_pk_bf16(y0[2], y0[3]); w.z = cvt_pk_bf16(y1[0], y1[1]); w.w = cvt_pk_bf16(y1[2], y1[3]);
                *(u32x4*)(H + (size_t)(t0 + r) * DM + 8 * lane + 512 * q) = w;
            }
        }
    }
}
__device__ __forceinline__ void load_residual(const float* x, const float* ctx, bf16_t* xr, int t_begin, int t_end, int lane) {
    for (int t0 = t_begin; t0 < t_end; t0 += 2) {
        f32x4 v[2][4];
#pragma unroll
        for (int r = 0; r < 2; ++r) {
            const int t = (t0 + r < t_end) ? t0 + r : t0; const int b = t / TPB, j = t % TPB;
            const float* src = (j < CTX) ? ctx + ((size_t)b * CTX + j) * DM : x + ((size_t)b * SEQ + (j - CTX)) * DM;
#pragma unroll
            for (int q = 0; q < 4; ++q) v[r][q] = *(const f32x4*)(src + 8 * lane + 512 * (q >> 1) + 4 * (q & 1));
        }
#pragma unroll
        for (int r = 0; r < 2; ++r) {
            if (t0 + r >= t_end) break;
#pragma unroll
            for (int q = 0; q < 2; ++q) { const f32x4 a0 = v[r][2 * q], a1 = v[r][2 * q + 1];
                u32x4 w; w.x = cvt_pk_bf16(a0[0], a0[1]); w.y = cvt_pk_bf16(a0[2], a0[3]); w.z = cvt_pk_bf16(a1[0], a1[1]); w.w = cvt_pk_bf16(a1[2], a1[3]);
                *(u32x4*)(xr + (size_t)(t0 + r) * DM + 8 * lane + 512 * q) = w; }
        }
    }
}
__device__ __forceinline__ void norm_rows_in(int t_begin, int t_end, const float* x, const float* ctx, bf16_t* xr, const float* modl, int sh_off, int sc_off, const float* gain, bf16_t* H, int lane) {
    f32x4 g[4];
#pragma unroll
    for (int q = 0; q < 4; ++q) g[q] = *(const f32x4*)(gain + 8 * lane + 512 * (q >> 1) + 4 * (q & 1));
    for (int t0 = t_begin; t0 < t_end; t0 += 2) {
        f32x4 vin[2][4], sh[2][4], sc[2][4];
#pragma unroll
        for (int r = 0; r < 2; ++r) {
            const int t = (t0 + r < t_end) ? t0 + r : t0; const int b = t / TPB, j = t % TPB;
            const float* src = (j < CTX) ? ctx + ((size_t)b * CTX + j) * DM : x + ((size_t)b * SEQ + (j - CTX)) * DM;
            const float* mp = modl + (size_t)(j < CTX ? 16 : b) * NMOD;
#pragma unroll
            for (int q = 0; q < 4; ++q) { const int k = 8 * lane + 512 * (q >> 1) + 4 * (q & 1); vin[r][q] = *(const f32x4*)(src + k); sh[r][q] = *(const f32x4*)(mp + sh_off + k); sc[r][q] = *(const f32x4*)(mp + sc_off + k); }
        }
#pragma unroll
        for (int r = 0; r < 2; ++r) {
            if (t0 + r >= t_end) break;
            f32x4 v[4]; float ss = 0.f;
#pragma unroll
            for (int q = 0; q < 2; ++q) { const f32x4 a0 = vin[r][2 * q], a1 = vin[r][2 * q + 1];
                u32x4 w; w.x = cvt_pk_bf16(a0[0], a0[1]); w.y = cvt_pk_bf16(a0[2], a0[3]); w.z = cvt_pk_bf16(a1[0], a1[1]); w.w = cvt_pk_bf16(a1[2], a1[3]);
                *(u32x4*)(xr + (size_t)(t0 + r) * DM + 8 * lane + 512 * q) = w;
                v[2 * q] = (f32x4){bf_lo(w.x), bf_hi(w.x), bf_lo(w.y), bf_hi(w.y)}; v[2 * q + 1] = (f32x4){bf_lo(w.z), bf_hi(w.z), bf_lo(w.w), bf_hi(w.w)}; }
#pragma unroll
            for (int q = 0; q < 4; ++q) ss += v[q][0] * v[q][0] + v[q][1] * v[q][1] + v[q][2] * v[q][2] + v[q][3] * v[q][3];
            const float rstd = rsqrtf(wave_sum(ss) * (1.0f / DM) + EPS);
#pragma unroll
            for (int q = 0; q < 2; ++q) {
                const f32x4 y0 = (v[2 * q] * rstd * g[2 * q]) * (sc[r][2 * q] + 1.0f) + sh[r][2 * q], y1 = (v[2 * q + 1] * rstd * g[2 * q + 1]) * (sc[r][2 * q + 1] + 1.0f) + sh[r][2 * q + 1];
                u32x4 w; w.x = cvt_pk_bf16(y0[0], y0[1]); w.y = cvt_pk_bf16(y0[2], y0[3]); w.z = cvt_pk_bf16(y1[0], y1[1]); w.w = cvt_pk_bf16(y1[2], y1[3]);
                *(u32x4*)(H + (size_t)(t0 + r) * DM + 8 * lane + 512 * q) = w;
            }
        }
    }
}
__device__ __forceinline__ void mid_rows(const Args& a, int l, int t_begin, int t_end, int lane) {
    const bf16_t* u = (const bf16_t*)(a.ws + WS_U); bf16_t* ucb = (bf16_t*)(a.ws + WS_UC);
    const float* rssp = (const float*)(a.ws + WS_RSS); float* rstd = (float*)(a.ws + WS_RSTD);
    const int ch = 8 * lane;
    float cw[4][8], cb[8];
#pragma unroll
    for (int q = 0; q < 4; ++q)
#pragma unroll
        for (int i = 0; i < 8; ++i) cw[q][i] = a.in[15][((size_t)l * 4 + q) * LRU + ch + i];
#pragma unroll
    for (int i = 0; i < 8; ++i) cb[i] = a.in[16][(size_t)l * LRU + ch + i];
    for (int t0 = t_begin; t0 < t_end; t0 += 2) {
        u32x4 uu[2][4];
#pragma unroll
        for (int r = 0; r < 2; ++r) {
            const int t = (t0 + r < t_end) ? t0 + r : t0;
            const int j = t % TPB; const int tl = (j < CTX) ? j : j - CTX, len = (j < CTX) ? CTX : SEQ;
#pragma unroll
            for (int q = 0; q < 4; ++q) { const int tt = tl - 1 + q; uu[r][q] = (tt >= 0 && tt < len) ? *(const u32x4*)(u + (size_t)(t - 1 + q) * LRU + ch) : (u32x4){0u, 0u, 0u, 0u}; }
        }
#pragma unroll
        for (int r = 0; r < 2; ++r) {
            if (t0 + r >= t_end) break;
            const int t = t0 + r;
            {
                const float pv = (lane < 20) ? rssp[(size_t)t * 20 + lane] : 0.f;
                const float sq = wave_sum(lane < 12 ? pv : 0.f), skv = wave_sum(lane >= 12 ? pv : 0.f);
                if (lane == 0) { rstd[t] = rsqrtf(sq * (1.0f / QR) + EPS); rstd[T + t] = rsqrtf(skv * (1.0f / KVR) + EPS); }
            }
            float o[8];
#pragma unroll
            for (int i = 0; i < 8; ++i) o[i] = cb[i];
#pragma unroll
            for (int q = 0; q < 4; ++q) { const u32x4 w = uu[r][q];
                o[0] += bf_lo(w.x) * cw[q][0]; o[1] += bf_hi(w.x) * cw[q][1]; o[2] += bf_lo(w.y) * cw[q][2]; o[3] += bf_hi(w.y) * cw[q][3];
                o[4] += bf_lo(w.z) * cw[q][4]; o[5] += bf_hi(w.z) * cw[q][5]; o[6] += bf_lo(w.w) * cw[q][6]; o[7] += bf_hi(w.w) * cw[q][7]; }
            u32x4 rr; rr.x = cvt_pk_bf16(o[0], o[1]); rr.y = cvt_pk_bf16(o[2], o[3]); rr.z = cvt_pk_bf16(o[4], o[5]); rr.w = cvt_pk_bf16(o[6], o[7]);
            *(u32x4*)(ucb + (size_t)t * LRU + ch) = rr;
        }
    }
}
__device__ __forceinline__ void fin_rows(const Args& a, int l, int t_begin, int t_end, int lane) {
    const int h = lane >> 3, sub = lane & 7; const bool rl = sub < 4;
    float gk0[8], gk1[8];
    { const float* gk = a.in[14] + (size_t)l * DQK;
#pragma unroll
      for (int i = 0; i < 8; ++i) { gk0[i] = gk[8 * sub + i]; gk1[i] = rl ? gk[64 + 8 * sub + i] : 0.f; } }
    float inv[8];
#pragma unroll
    for (int i = 0; i < 8; ++i) inv[i] = __builtin_amdgcn_exp2f(-(float)i * (13.287712379549449f / 8.0f));
    const float sgn = (sub & 1) ? 1.0f : -1.0f;
    bf16_t* Kb = (bf16_t*)(a.ws + WS_K); const bf16_t* KR = (const bf16_t*)(a.ws + WS_KR);
    constexpr int NT = 3;
    for (int t0 = t_begin; t0 < t_end; t0 += NT) {
        u32x4 ka[NT], kr4[NT];
#pragma unroll
        for (int r = 0; r < NT; ++r) { const int t = (t0 + r < t_end) ? t0 + r : t0;
            ka[r] = *(const u32x4*)(Kb + (size_t)t * 768 + h * 96 + 8 * sub); kr4[r] = rl ? *(const u32x4*)(KR + (size_t)t * 32 + 8 * sub) : (u32x4){0u, 0u, 0u, 0u}; }
#pragma unroll
        for (int r = 0; r < NT; ++r) {
            if (t0 + r >= t_end) break;
            const int t = t0 + r, j = t % TPB; const bool lat = j >= CTX; const int tl = j - CTX;
            const float pos = lat ? (float)((sub < 2) ? (tl >> 6) : (tl & 63)) : 0.f;
            const u32x4 wa = ka[r], wr = kr4[r];
            float x[8] = {bf_lo(wa.x), bf_hi(wa.x), bf_lo(wa.y), bf_hi(wa.y), bf_lo(wa.z), bf_hi(wa.z), bf_lo(wa.w), bf_hi(wa.w)};
            float y[8] = {bf_lo(wr.x), bf_hi(wr.x), bf_lo(wr.y), bf_hi(wr.y), bf_lo(wr.z), bf_hi(wr.z), bf_lo(wr.w), bf_hi(wr.w)};
            float ss = 0.f;
#pragma unroll
            for (int i = 0; i < 8; ++i) ss += x[i] * x[i] + y[i] * y[i];
            ss += __shfl_xor(ss, 1); ss += __shfl_xor(ss, 2); ss += __shfl_xor(ss, 4);
            const float rstd = rsqrtf(ss * (1.0f / DQK) + EPS);
#pragma unroll
            for (int i = 0; i < 8; ++i) { x[i] *= rstd * gk0[i]; y[i] *= rstd * gk1[i]; }
            float o[8];
#pragma unroll
            for (int i = 0; i < 8; ++i) { const float ang = pos * inv[i]; const float py = __shfl_xor(y[i], 1); o[i] = y[i] * __cosf(ang) + py * (__sinf(ang) * sgn); }
            bf16_t* base = Kb + (size_t)t * 768 + h * 96;
            u32x4 w; w.x = cvt_pk_bf16(x[0], x[1]); w.y = cvt_pk_bf16(x[2], x[3]); w.z = cvt_pk_bf16(x[4], x[5]); w.w = cvt_pk_bf16(x[6], x[7]);
            *(u32x4*)(base + 8 * sub) = w;
            if (rl) { u32x4 rr; rr.x = cvt_pk_bf16(o[0], o[1]); rr.y = cvt_pk_bf16(o[2], o[3]); rr.z = cvt_pk_bf16(o[4], o[5]); rr.w = cvt_pk_bf16(o[6], o[7]);
                      *(u32x4*)(base + 64 + 8 * sub) = rr; }
        }
    }
}

constexpr float SSHIFT = 8.0f;
constexpr int KPITCH = 208, VPITCH = 144, KBUF = 64 * KPITCH, VBUF = 64 * VPITCH;
__device__ __forceinline__ void attn_unit(LAS unsigned char* lds, const bf16_t* Q, const bf16_t* Kb, const bf16_t* VT, bf16_t* cat, const float* qgain, const bool rope_on, int h, int qrow0, int krow0, int nk, const int tid) {
    const int wid = tid >> 6, lane = tid & 63, l32 = lane & 31, hi = lane >> 5;
    const bf16_t* qp = Q + (size_t)(qrow0 + wid * 32 + l32) * 768 + h * 96 + 8 * hi;
    bf16x8 qf[6];
    {
        u32x4 raw[6]; float ss = 0.f;
#pragma unroll
        for (int ks = 0; ks < 6; ++ks) { raw[ks] = *(const u32x4*)(qp + 16 * ks);
            const float a0 = bf_lo(raw[ks].x), a1 = bf_hi(raw[ks].x), a2 = bf_lo(raw[ks].y), a3 = bf_hi(raw[ks].y), a4 = bf_lo(raw[ks].z), a5 = bf_hi(raw[ks].z), a6 = bf_lo(raw[ks].w), a7 = bf_hi(raw[ks].w);
            ss += (a0 * a0 + a1 * a1) + (a2 * a2 + a3 * a3) + (a4 * a4 + a5 * a5) + (a6 * a6 + a7 * a7); }
        ss += __shfl_xor(ss, 32);
        const float rstd = rsqrtf(ss * (1.0f / DQK) + EPS) * QSCALE;
        const int tl = (qrow0 - krow0 - CTX) + wid * 32 + l32;
        const float sgn = hi ? 1.0f : -1.0f;
#pragma unroll
        for (int ks = 0; ks < 6; ++ks) {
            const f32x4 g0 = *(const f32x4*)(qgain + 16 * ks + 8 * hi), g1 = *(const f32x4*)(qgain + 16 * ks + 8 * hi + 4);
            float y[8] = {bf_lo(raw[ks].x) * rstd * g0[0], bf_hi(raw[ks].x) * rstd * g0[1], bf_lo(raw[ks].y) * rstd * g0[2], bf_hi(raw[ks].y) * rstd * g0[3],
                          bf_lo(raw[ks].z) * rstd * g1[0], bf_hi(raw[ks].z) * rstd * g1[1], bf_lo(raw[ks].w) * rstd * g1[2], bf_hi(raw[ks].w) * rstd * g1[3]};
            if (ks >= 4) {
                const float pos = rope_on ? (float)((ks == 4) ? (tl >> 6) : (tl & 63)) : 0.f;
#pragma unroll
                for (int i = 0; i < 8; ++i) { const float ang = pos * __builtin_amdgcn_exp2f(-(float)i * (13.287712379549449f / 8.0f)); const float py = __shfl_xor(y[i], 32);
                    y[i] = y[i] * __cosf(ang) + py * (__sinf(ang) * sgn); }
            }
            u32x4 w; w.x = cvt_pk_bf16(y[0], y[1]); w.y = cvt_pk_bf16(y[2], y[3]); w.z = cvt_pk_bf16(y[4], y[5]); w.w = cvt_pk_bf16(y[6], y[7]);
            qf[ks] = __builtin_bit_cast(bf16x8, w);
        }
    }
    f32x16 o0, o1;
#pragma unroll
    for (int i = 0; i < 16; ++i) { o0[i] = 0.f; o1[i] = 0.f; }
    float lsum = 0.f;
    const int ntiles = nk / 64;
    const int kr0 = tid / 12, kc0 = tid % 12, kr1 = (tid + 512) / 12, kc1 = (tid + 512) % 12;
    const int vr = tid >> 3, vc = tid & 7;
    const bf16_t* kg0 = Kb + (size_t)(krow0 + kr0) * 768 + h * 96 + kc0 * 8;
    const bf16_t* kg1 = Kb + (size_t)(krow0 + kr1) * 768 + h * 96 + kc1 * 8;
    const bf16_t* vg = VT + (size_t)(h * 64 + vr) * T + krow0 + vc * 8;
    const int kl0 = kr0 * KPITCH + kc0 * 16, kl1 = kr1 * KPITCH + kc1 * 16;
    const int vl = 3 * KBUF + vr * VPITCH + (vc >> 1) * 32 + (vc & 1) * 8;
    const bool two = tid < 256;
    u32x4 rk0, rk1 = (u32x4){0, 0, 0, 0}, rv;
#define ATT_LDK(tt) do { rk0 = *(const u32x4*)(kg0 + (size_t)(tt) * 64 * 768); if (two) rk1 = *(const u32x4*)(kg1 + (size_t)(tt) * 64 * 768); } while (0)
#define ATT_STK(slot) do { *(LAS u32x4*)(lds + (slot) * KBUF + kl0) = rk0; if (two) *(LAS u32x4*)(lds + (slot) * KBUF + kl1) = rk1; } while (0)
#define ATT_LDV(tt) do { rv = *(const u32x4*)(vg + (tt) * 64); } while (0)
#define ATT_STV(slot) do { *(LAS u32x2*)(lds + (slot) * VBUF + vl) = (u32x2){rv.x, rv.y}; *(LAS u32x2*)(lds + (slot) * VBUF + vl + 16) = (u32x2){rv.z, rv.w}; } while (0)
#define ATT_QK(S0, S1, slot) do { const LAS unsigned char* kb = lds + (slot) * KBUF; _Pragma("unroll") for (int i = 0; i < 16; ++i) { S0[i] = -SSHIFT; S1[i] = -SSHIFT; } \
        _Pragma("unroll") for (int ks = 0; ks < 6; ++ks) { \
            const bf16x8 a0 = *(const LAS bf16x8*)(kb + l32 * KPITCH + ks * 32 + hi * 16); const bf16x8 a1 = *(const LAS bf16x8*)(kb + (32 + l32) * KPITCH + ks * 32 + hi * 16); \
            S0 = __builtin_amdgcn_mfma_f32_32x32x16_bf16(a0, qf[ks], S0, 0, 0, 0); S1 = __builtin_amdgcn_mfma_f32_32x32x16_bf16(a1, qf[ks], S1, 0, 0, 0); } } while (0)
#define ATT_EXP1(C0, C1, fi) do { if ((fi) < 16) { C0[(fi) & 15] = __builtin_amdgcn_exp2f(C0[(fi) & 15]); ps += C0[(fi) & 15]; } else if ((fi) < 32) { C1[(fi) & 15] = __builtin_amdgcn_exp2f(C1[(fi) & 15]); ps += C1[(fi) & 15]; } } while (0)
#define ATT_STEP(C0, C1, N0, N1, tt, ks_next, ks_store, vs_cur, vs_store) do { \
        const bool h1 = (tt) + 1 < ntiles, h2 = (tt) + 2 < ntiles; \
        if (h2) ATT_LDK((tt) + 2); \
        if (h1) ATT_LDV((tt) + 1); \
        float ps = 0.f; \
        { const LAS unsigned char* kb = lds + (ks_next) * KBUF; _Pragma("unroll") for (int i = 0; i < 16; ++i) { N0[i] = -SSHIFT; N1[i] = -SSHIFT; } \
          __builtin_amdgcn_sched_barrier(0); \
          _Pragma("unroll") for (int ks = 0; ks < 6; ++ks) {     \
            const bf16x8 a0 = *(const LAS bf16x8*)(kb + l32 * KPITCH + ks * 32 + hi * 16); const bf16x8 a1 = *(const LAS bf16x8*)(kb + (32 + l32) * KPITCH + ks * 32 + hi * 16); \
            N0 = __builtin_amdgcn_mfma_f32_32x32x16_bf16(a0, qf[ks], N0, 0, 0, 0); N1 = __builtin_amdgcn_mfma_f32_32x32x16_bf16(a1, qf[ks], N1, 0, 0, 0); \
            _Pragma("unroll") for (int e_ = 0; e_ < 6; ++e_) ATT_EXP1(C0, C1, ks * 6 + e_); \
            __builtin_amdgcn_sched_barrier(0); } } \
        lsum += ps; \
        if (h2) ATT_STK(ks_store); \
        if (h1) ATT_STV(vs_store); \
        bf16x8 pf[4]; \
        _Pragma("unroll") for (int jj = 0; jj < 2; ++jj) { u32x4 w0, w1; \
            w0.x = cvt_pk_bf16(C0[8 * jj + 0], C0[8 * jj + 1]); w0.y = cvt_pk_bf16(C0[8 * jj + 2], C0[8 * jj + 3]); w0.z = cvt_pk_bf16(C0[8 * jj + 4], C0[8 * jj + 5]); w0.w = cvt_pk_bf16(C0[8 * jj + 6], C0[8 * jj + 7]); \
            w1.x = cvt_pk_bf16(C1[8 * jj + 0], C1[8 * jj + 1]); w1.y = cvt_pk_bf16(C1[8 * jj + 2], C1[8 * jj + 3]); w1.z = cvt_pk_bf16(C1[8 * jj + 4], C1[8 * jj + 5]); w1.w = cvt_pk_bf16(C1[8 * jj + 6], C1[8 * jj + 7]); \
            pf[jj] = __builtin_bit_cast(bf16x8, w0); pf[2 + jj] = __builtin_bit_cast(bf16x8, w1); } \
        { const LAS unsigned char* vb = lds + 3 * KBUF + (vs_cur) * VBUF; \
          _Pragma("unroll") for (int jj = 0; jj < 4; ++jj) { \
            const bf16x8 v0 = *(const LAS bf16x8*)(vb + l32 * VPITCH + jj * 32 + hi * 16); const bf16x8 v1 = *(const LAS bf16x8*)(vb + (32 + l32) * VPITCH + jj * 32 + hi * 16); \
            o0 = __builtin_amdgcn_mfma_f32_32x32x16_bf16(v0, pf[jj], o0, 0, 0, 0); o1 = __builtin_amdgcn_mfma_f32_32x32x16_bf16(v1, pf[jj], o1, 0, 0, 0); } } \
        __syncthreads(); } while (0)
    ATT_LDK(0); ATT_LDV(0);
    const u32x4 kx0 = *(const u32x4*)(kg0 + (size_t)64 * 768); u32x4 kx1 = (u32x4){0, 0, 0, 0}; if (two) kx1 = *(const u32x4*)(kg1 + (size_t)64 * 768);
    ATT_STK(0); ATT_STV(0);
    rk0 = kx0; rk1 = kx1; ATT_STK(1);
    __syncthreads();
    f32x16 sa0, sa1, sb0, sb1;
    ATT_QK(sa0, sa1, 0);
    int k0s = 0;
    for (int t = 0; t < ntiles; t += 2) {
        const int k1s = (k0s == 2) ? 0 : k0s + 1, k2s = (k1s == 2) ? 0 : k1s + 1;
        ATT_STEP(sa0, sa1, sb0, sb1, t, k1s, k2s, 0, 1);
        ATT_STEP(sb0, sb1, sa0, sa1, t + 1, k2s, k0s, 1, 0);
        k0s = k2s;
    }
#undef ATT_LDK
#undef ATT_STK
#undef ATT_LDV
#undef ATT_STV
#undef ATT_QK
#undef ATT_STEP
#undef ATT_EXP1
    const float ltot = lsum + __shfl_xor(lsum, 32), inv = __builtin_amdgcn_rcpf(ltot);
    bf16_t* op = cat + (size_t)(qrow0 + wid * 32 + l32) * DM + h * 64 + 4 * hi;
#pragma unroll
    for (int q = 0; q < 4; ++q) {
        u32x2 w; w.x = cvt_pk_bf16(o0[4 * q] * inv, o0[4 * q + 1] * inv); w.y = cvt_pk_bf16(o0[4 * q + 2] * inv, o0[4 * q + 3] * inv);
        *(u32x2*)(op + 8 * q) = w;
        w.x = cvt_pk_bf16(o1[4 * q] * inv, o1[4 * q + 1] * inv); w.y = cvt_pk_bf16(o1[4 * q + 2] * inv, o1[4 * q + 3] * inv);
        *(u32x2*)(op + 32 + 8 * q) = w;
    }
}
__device__ __forceinline__ void attn_phase(const Args& a, int l, LAS unsigned char* lds, const int tid, const int bid) {
    const bf16_t* Q = (const bf16_t*)(a.ws + WS_Q); const bf16_t* Kb = (const bf16_t*)(a.ws + WS_K); const bf16_t* VT = (const bf16_t*)(a.ws + WS_VT);
    bf16_t* cat = (bf16_t*)a.out;
    const int nunits = (l == DEPTH - 1) ? 1024 : 1152;
    for (int i = bid; i < nunits; i += gridDim.x) {
        int pair, qb;
        if (i < 1024) { const int r = i >> 8, c = i & 255; pair = r * 32 + (c & 7) * 4 + (c >> 6); qb = ((c >> 3) & 7) + 1; }
        else { pair = i - 1024; qb = 0; }
        const int b = pair >> 3, h = pair & 7;
        attn_unit(lds, Q, Kb, VT, cat, a.in[13] + (size_t)l * DQK, qb != 0, h, b * TPB + qb * 256, b * TPB, qb == 0 ? CTX : TPB, tid);
    }
}

__device__ __forceinline__ void scan_s1(const Args& a, const int tid, const int bid) {
    const unsigned* ab = (const unsigned*)(a.ws + WS_AB); float* sums = (float*)(a.ws + WS_SUMS);
    const int ch = tid;
    for (int it = bid; it < NB * NCHUNK * 2; it += gridDim.x) {
        const int d = it & 1, bc = it >> 1, b = bc / NCHUNK, c = bc % NCHUNK, t0 = b * TPB + c * 64;
        float hs = 0.f, sl = 0.f;
#pragma unroll 8
        for (int i = 0; i < 64; ++i) {
            const int t = d == 0 ? t0 + i : t0 + 63 - i;
            const h16x2 v = __builtin_bit_cast(h16x2, ab[((size_t)t * 2 + d) * 512 + ch]);
            const float la = (float)v.x, bb = (float)v.y;
            hs = __expf(la) * hs + bb; sl += la;
        }
        *(float2*)(sums + (((size_t)bc * 2 + d) * 512 + ch) * 2) = make_float2(sl, hs);
    }
}
__device__ __forceinline__ void scan_s3(const Args& a, const int tid, const int bid, const int last) {
    const unsigned* ab = (const unsigned*)(a.ws + WS_AB); const float* sums = (const float*)(a.ws + WS_SUMS);
    const bf16_t* g = (const bf16_t*)(a.ws + WS_G); bf16_t* cat = (bf16_t*)a.out;
    const int ch = tid;
    const bool deal = (gridDim.x == 256);
    for (int k = 0; k < 3; ++k) {
        int bc = bid + (int)gridDim.x * k;
        if (deal && k == 2) bc = (bid >= 128 && bid < 192) ? bid - 128 + 512 : NB * NCHUNK;
        if (bc >= NB * NCHUNK) break;
        const int b = bc / NCHUNK, c = bc % NCHUNK, t0 = b * TPB + c * 64;
        if (last && c < 4) continue;
        const float* sb = sums + (size_t)b * NCHUNK * 2 * 512 * 2;
        float hf = 0.f, hb = 0.f;
        {
            float2 v[NCHUNK];
#pragma unroll
            for (int k = 0; k < NCHUNK; ++k) v[k] = *(const float2*)(sb + (((size_t)k * 2 + 0) * 512 + ch) * 2);
#pragma unroll
            for (int k = 0; k < NCHUNK; ++k) { const bool use = k < c; const float aa = use ? __expf(v[k].x) : 1.0f, bb = use ? v[k].y : 0.f; hf = aa * hf + bb; }
            const int pos = (c < 4) ? 3 - c : 4 + (NCHUNK - 1 - c);
#pragma unroll
            for (int k = 0; k < NCHUNK; ++k) { const int cc = (k < 4) ? 3 - k : NCHUNK + 3 - k; v[k] = *(const float2*)(sb + (((size_t)cc * 2 + 1) * 512 + ch) * 2); }
#pragma unroll
            for (int k = 0; k < NCHUNK; ++k) { const bool use = k < pos; const float aa = use ? __expf(v[k].x) : 1.0f, bb = use ? v[k].y : 0.f; hb = aa * hb + bb; }
        }
        float hfs[64];
#pragma unroll
        for (int i = 0; i < 64; ++i) {
            const h16x2 v = __builtin_bit_cast(h16x2, __builtin_nontemporal_load(ab + ((size_t)(t0 + i) * 2 + 0) * 512 + ch));
            hf = __expf((float)v.x) * hf + (float)v.y; hfs[i] = hf;
        }
#pragma unroll
        for (int i0 = 48; i0 >= 0; i0 -= 16) {
            unsigned av[16]; bf16_t gv[16];
#pragma unroll
            for (int j = 0; j < 16; ++j) { av[j] = __builtin_nontemporal_load(ab + ((size_t)(t0 + i0 + j) * 2 + 1) * 512 + ch); gv[j] = __builtin_nontemporal_load(g + (size_t)(t0 + i0 + j) * 512 + ch); }
#pragma unroll
            for (int j = 15; j >= 0; --j) {
                const h16x2 v = __builtin_bit_cast(h16x2, av[j]);
                hb = __expf((float)v.x) * hb + (float)v.y;
                cat[(size_t)(t0 + i0 + j) * DM + 512 + ch] = f2bf((hfs[i0 + j] + hb) * gelu_tanh(bf1(gv[j])));
            }
        }
    }
}

#define XB_TMO      128
#define XB_XCNT(j)  (256  + 64 * (j))
#define XB_XSUB(j)  (1280 + 64 * (j))
#define XB_XGEN(j)  (2304 + 64 * (j))
#define XB_TOP      3328
#define XB_TOPGEN   3392
#define XCD_BAR_WORDS 3456
#define XB_SPIN_CAP (1u << 18)

__device__ __forceinline__ unsigned xb_ld(unsigned* p)              { return __hip_atomic_load(p, __ATOMIC_RELAXED, __HIP_MEMORY_SCOPE_AGENT); }
__device__ __forceinline__ unsigned xb_add(unsigned* p, unsigned v) { return __hip_atomic_fetch_add(p, v, __ATOMIC_RELAXED, __HIP_MEMORY_SCOPE_AGENT); }
__device__ __forceinline__ unsigned xb_xcc_id() { return (unsigned)__builtin_amdgcn_s_getreg((3 << 11) | 20) & 0xFu; }
#define XB_SPIN(cond, bar) do { unsigned _sp = 0; while (cond) { __builtin_amdgcn_s_sleep(1); \
    if ((++_sp & 255u) == 0u) { if (xb_ld(&(bar)[XB_TMO])) break; if (_sp > XB_SPIN_CAP) { atomicAdd(&(bar)[XB_TMO], 1u); break; } } } } while (0)

struct XcdBarrier {
    unsigned* bar; unsigned x;
    volatile LAS unsigned* st;
};

__device__ __forceinline__ XcdBarrier xcd_barrier_post(unsigned* bar, volatile LAS unsigned* st) {
    XcdBarrier b; b.bar = bar; b.x = xb_xcc_id(); b.st = st;
    if (threadIdx.x == 0) (void)xb_add(&bar[XB_XCNT(b.x)], 1u);
    return b;
}
__device__ __forceinline__ void xcd_barrier_complete(unsigned* bar, unsigned x, unsigned& nloc, unsigned& nx) {
    const unsigned G = gridDim.x * gridDim.y * gridDim.z;
    unsigned sum, cnt, mine, sp = 0u;
    for (;;) {
        sum = 0u; cnt = 0u; mine = 0u;
#pragma unroll
        for (unsigned j = 0; j < 16; ++j) { const unsigned c = xb_ld(&bar[XB_XCNT(j)]); sum += c; cnt += (c > 0u) ? 1u : 0u; mine = (j == x) ? c : mine; }
        if (sum == G) break;
        __builtin_amdgcn_s_sleep(1);
        if ((++sp & 255u) == 0u) { if (xb_ld(&bar[XB_TMO])) break; if (sp > XB_SPIN_CAP) { atomicAdd(&bar[XB_TMO], 1u); break; } }
    }
    nloc = mine > 0u ? mine : 1u; nx = cnt > 0u ? cnt : 1u;
}

__device__ __forceinline__ void xcd_barrier(const XcdBarrier& b) {
    asm volatile("s_waitcnt vmcnt(0)" ::: "memory");
    __syncthreads();
    if (threadIdx.x == 0) {
        unsigned* bar = b.bar;
        __builtin_amdgcn_s_waitcnt(0);
        unsigned nloc = b.st[0], nx = b.st[1];
        if (nloc == 0u) { xcd_barrier_complete(bar, b.x, nloc, nx); b.st[0] = nloc; b.st[1] = nx; }
        const unsigned old = xb_add(&bar[XB_XSUB(b.x)], 1u);
        const unsigned gen = old / nloc;
        if (old + 1u == (gen + 1u) * nloc) {
            __builtin_amdgcn_fence(__ATOMIC_RELEASE, "agent");
            asm volatile("s_waitcnt vmcnt(0)" ::: "memory");
            const unsigned og = xb_add(&bar[XB_TOP], 1u);
            const unsigned tg = og / nx;
            if (og + 1u == (tg + 1u) * nx) xb_add(&bar[XB_TOPGEN], 1u);
            else XB_SPIN(xb_ld(&bar[XB_TOPGEN]) == tg, bar);
            __builtin_amdgcn_fence(__ATOMIC_ACQUIRE, "agent");
            xb_add(&bar[XB_XGEN(b.x)], 1u);
            asm volatile("s_waitcnt vmcnt(0)" ::: "memory");
        } else {
            XB_SPIN(xb_ld(&bar[XB_XGEN(b.x)]) == gen, bar);
            __builtin_amdgcn_fence(__ATOMIC_ACQUIRE, "agent");
            asm volatile("s_waitcnt vmcnt(0)" ::: "memory");
        }
    }
    __syncthreads();
}


__device__ __forceinline__ int fresh_lane() { int l; asm volatile("v_mbcnt_lo_u32_b32 %0, -1, 0\n\tv_mbcnt_hi_u32_b32 %0, -1, %0" : "=v"(l)); return l; }
#ifndef PHASE_MASK
#define PHASE_MASK 0xFFF
#endif
#ifndef P3SEL
#define P3SEL 7
#endif
#define PH_ON(k) (((PHASE_MASK) >> (k)) & 1)
#ifndef PROBE_REP_MASK
#define PROBE_REP_MASK 0
#endif
#ifndef PROBE_CASE
#define PROBE_CASE -1
#endif
#ifndef PROBE_N
#define PROBE_N 2
#endif
#define REPS(k) for (int rep_ = 0; rep_ < ((PROBE_CASE == (k)) ? PROBE_N : 1); ++rep_)
constexpr int PPL = 10, PPLX = PPL + __builtin_popcount(PROBE_REP_MASK), NPHASE = 1 + DEPTH * PPLX;
typedef const __attribute__((address_space(4))) Args* ArgsP;
#define LD_IN(k) la.in[k] = ap->in[k]
__global__ void __launch_bounds__(512) fwd_kernel(Args a_unused) {
    extern __shared__ __attribute__((aligned(16))) unsigned char lds_raw[];
    LAS unsigned char* lds = (LAS unsigned char*)lds_raw;
    const int G = gridDim.x, NGW = G * 8;
    const int wid0 = __builtin_amdgcn_readfirstlane((int)threadIdx.x >> 6);
    ArgsP ap0 = (ArgsP)__builtin_amdgcn_kernarg_segment_ptr();
    const int ph_lo = ap0->ph_lo, ph_hi = ap0->ph_hi;
    volatile LAS unsigned* bst = (volatile LAS unsigned*)(lds + LDS_BARST);
    if (threadIdx.x < 2) bst[threadIdx.x] = 0u;
    __syncthreads();
    const XcdBarrier xbar = xcd_barrier_post((unsigned*)(ap0->ws + WS_BAR), bst);
    for (int ph = ph_lo; ph < ph_hi; ++ph) {
        if (ph > ph_lo) { if (ph == ph_lo + 1) cg::this_grid().sync(); else xcd_barrier(xbar); }
        ArgsP ap = ap0; asm volatile("" : "+s"(ap));
        int wid_ = wid0, bid_ = blockIdx.x; asm volatile("" : "+s"(wid_)); asm volatile("" : "+s"(bid_));
        const int wid = wid_, bid = bid_, gw = bid * 8 + wid;
#define TID (wid * 64 + fresh_lane())
#define LANE (fresh_lane())
        Args la; la.ws = ap->ws; la.out = ap->out;
        unsigned char* ws = la.ws;
        if (ph == 0) { if (PH_ON(11)) { LD_IN(1); LD_IN(3); LD_IN(4); LD_IN(5); mod_phase(la, lds, TID, 0, 96, bid, G); } continue; }
        const int l = (ph - 1) / PPLX; int lp = (ph - 1) % PPLX; if (!PROBE_REP_MASK && lp >= 6) lp += 1;
        int probe_first = 0;
        if (PROBE_REP_MASK) { const int e = lp; int cnt = 0; for (int q = 0; q < PPL; ++q) { const int n = 1 + ((PROBE_REP_MASK >> q) & 1); if (e < cnt + n) { lp = q; probe_first = (n == 2 && e == cnt) ? 1 : 0; break; } cnt += n; } }
        const float* modl = (const float*)(ws + WS_MOD) + (size_t)l * 17 * NMOD;
        bf16_t* wt = (bf16_t*)(ws + WS_WT);
        bf16_t* H = (bf16_t*)la.out;
        bf16_t* xr = (bf16_t*)(ws + WS_XR);
        pg8::StaticOrder S;
        const int last = (l == DEPTH - 1) ? 1 : 0;
        switch (lp) {
        case 0: if (PH_ON(0)) REPS(0) {
            LD_IN(8); LD_IN(9); LD_IN(10); LD_IN(11); LD_IN(12); LD_IN(17); LD_IN(19); LD_IN(22); LD_IN(23); LD_IN(24);
            if (l == 0) convert_weights(la, l, lds, gw, NGW, wid, LANE);
            if (bid == G - 1) { const float* lam = ap->in[21] + (size_t)l * 1024; float* sp8 = (float*)(ws + WS_SP);
                for (int i = TID; i < 1024; i += 512) { const float z = -lam[i]; const float e = __expf(-fabsf(z)); const float lp = e < 0.03f ? e * (1.0f - e * (0.5f - e * (0.33333334f - 0.25f * e))) : __logf(1.0f + e); sp8[i] = 8.0f * (fmaxf(z, 0.f) + lp); } }
            const float* gain = ap->in[6] + (size_t)l * DM;
            { const int per = (T + NGW - 1) / NGW, tb = gw * per, te = (tb + per < T) ? tb + per : T;
              if (l == 0) norm_rows_in(tb, te, ap->in[0], ap->in[2], xr, modl, 0, DM, gain, H, LANE); else norm_rows(tb, te, xr, modl, 0, DM, gain, H, LANE, nullptr); }
        } break;
        case 1: if (PH_ON(1)) REPS(1) {
            pg8::Gemm g{H, wt + WT_IN / 2, T, IN_PAD, DM, DM, DM}; S.init(T, IN_PAD, G, bid);
            pg8::EpiStore<1> E{nullptr, 0, (bf16_t*)(ws + WS_CQ), (bf16_t*)(ws + WS_CKV), (bf16_t*)(ws + WS_KR), (bf16_t*)(ws + WS_U), (bf16_t*)(ws + WS_G), (float*)(ws + WS_RSS), nullptr, 0.f, 0};
            pg8::gemm_phase<pg8::EpiStore<1>, true>(lds, g, S, E, TID);
        } break;
        case 2: if (PH_ON(2)) REPS(2) { LD_IN(15); LD_IN(16); const int per = (T + NGW - 1) / NGW, tb = gw * per, te = (tb + per < T) ? tb + per : T; mid_rows(la, l, tb, te, LANE); } break;
        case 3: if (PH_ON(3)) REPS(3) {
            if (P3SEL & 1) { pg8::Gemm g{(const bf16_t*)(ws + WS_CQ), wt + WT_UQ / 2, T, 768, QR, QR, QR}; S.init(last ? TLAT : T, 768, G, bid, last);
              pg8::EpiStore<0> E{(bf16_t*)(ws + WS_Q), 768, nullptr, nullptr, nullptr, nullptr, nullptr, nullptr, (const float*)(ws + WS_RSTD), 1.0f / QR, 0};
              pg8::gemm_phase<pg8::EpiStore<0>, true>(lds, g, S, E, TID); }
            if (P3SEL & 2) { pg8::Gemm g{(const bf16_t*)(ws + WS_CKV), wt + WT_KN / 2, T, 512, KVR, KVR, KVR}; S.init(T, 512, G, (bid + 80) % G);
              pg8::EpiStore<2> E{(bf16_t*)(ws + WS_K), 768, nullptr, nullptr, nullptr, nullptr, nullptr, nullptr, (const float*)(ws + WS_RSTD) + T, 1.0f / KVR, 0};
              pg8::gemm_phase<pg8::EpiStore<2>, true>(lds, g, S, E, TID); }
            if (P3SEL & 4) { pg8::Gemm g{wt + WT_VT / 2, (const bf16_t*)(ws + WS_CKV), 512, T, KVR, KVR, KVR}; S.init(512, T, G, (bid + 48) % G);
              pg8::EpiStore<0> E{(bf16_t*)(ws + WS_VT), T, nullptr, nullptr, nullptr, nullptr, nullptr, nullptr, (const float*)(ws + WS_RSTD) + T, 1.0f / KVR, 1};
              pg8::gemm_phase<pg8::EpiStore<0>, true>(lds, g, S, E, TID); }
        } break;
        case 4: if (PH_ON(4)) {
            LD_IN(14);
            const float* ba = ap->in[18] + (size_t)l * 1024; const float* bx = ap->in[20] + (size_t)l * 1024;
            for (int half_ = 0; half_ < 2; ++half_) if ((half_ ^ (bid & 1)) == 0) {
            { pg8::EpiGates E{ba, bx, (const float*)(ws + WS_SP), (const bf16_t*)(ws + WS_UC), (unsigned*)(ws + WS_AB)};
              REPS(4) gates_phase(lds, (const bf16_t*)(ws + WS_UC), wt + WT_G0 / 2, E, (float*)(ws + WS_SUMS), TID, bid, G); }
            } else {
            if (!probe_first) { const int per = (T + NGW - 1) / NGW, tb = gw * per, te = (tb + per < T) ? tb + per : T; fin_rows(la, l, tb, te, LANE); }
            }
        } break;
        case 5: if (PH_ON(5)) REPS(5) { LD_IN(13);
            for (int half_ = 0; half_ < 2; ++half_) { if ((half_ ^ (bid & 1)) == 0) attn_phase(la, l, lds, TID, bid); else { REPS(6) scan_s3(la, TID, bid, last); } } } break;
        case 7: if (PH_ON(7)) {
            pg8::Gemm g{H, wt + WT_OUT / 2, T, DM, DM, DM, DM}; S.init(last ? TLAT : T, DM, G, bid, last);
            pg8::EpiResid<false> E{modl + 2 * DM, xr, nullptr};
            pg8::gemm_phase<pg8::EpiResid<false>, true>(lds, g, S, E, TID);
            if (!last) {
                const int nx = ((T / 256) * (DM / 256)) % G, idle = G - nx;
                if (bid >= nx && bid - nx < 96) { LD_IN(1); LD_IN(3); LD_IN(4); LD_IN(5); mod_phase(la, lds, TID, 96 * (l + 1), 96 * (l + 2), bid - nx, idle); }
            }
        } break;
        case 8: if (PH_ON(8)) REPS(8) { const float* gain = ap->in[7] + (size_t)l * DM; const int per = (T + NGW - 1) / NGW, tb = gw * per, te = (tb + per < T) ? tb + per : T; norm_rows(tb, te, xr, modl, 3 * DM, 4 * DM, gain, H, LANE, nullptr); } break;
        case 9: if (PH_ON(9)) REPS(9) {
            pg8::Gemm g{H, wt + WT_FFI / 2, T, 2 * DFF, DM, DM, DM}; S.init(last ? TLAT : T, 2 * DFF, G, bid, last);
            pg8::EpiSwiglu E{(bf16_t*)(ws + WS_FF)};
            pg8::gemm_phase<pg8::EpiSwiglu, true>(lds, g, S, E, TID);
        } break;
        default: if (PH_ON(10)) {
            pg8::Gemm g{(const bf16_t*)(ws + WS_FF), wt + ((l & 1) ? (WS_FFO_ALT - WS_WT) : WT_FFO) / 2, T, DM, DFF, DFF, DFF}; S.init(last ? TLAT : T, DM, G, bid, last);
            if (last) { pg8::EpiResid<true> E{modl + 5 * DM, xr, la.out}; pg8::gemm_phase<pg8::EpiResid<true>, true>(lds, g, S, E, TID); }
            else { pg8::EpiResid<false> E{modl + 5 * DM, xr, nullptr}; pg8::gemm_phase<pg8::EpiResid<false>, true>(lds, g, S, E, TID); }
            if (!last) {
                const int nx = ((T / 256) * (DM / 256)) % G;
                if (bid >= nx) { LD_IN(8); LD_IN(9); LD_IN(10); LD_IN(11); LD_IN(12); LD_IN(17); LD_IN(19); LD_IN(22); LD_IN(23); LD_IN(24);
                    convert_weights(la, l + 1, lds, (bid - nx) * 8 + wid, (G - nx) * 8, wid, LANE); }
            }
        } break;
        }
    }
}

#undef TID
#undef LANE
extern "C" void kernel_launch(void* const* d_in, const int* in_sizes, int n_in, void* d_out, int out_size, void* d_ws, size_t ws_size, hipStream_t stream) {
    static int grid = 0;
    if (grid == 0) {
        if (n_in != 25 || out_size != NB * SEQ * DM || ws_size < WS_END) { fprintf(stderr, "kernel_launch: unexpected shapes (n_in %d out %d ws %zu)\n", n_in, out_size, ws_size); grid = -1; return; }
        int dev = 0, cus = 0, per_cu = 0;
        hipGetDevice(&dev); hipDeviceGetAttribute(&cus, hipDeviceAttributeMultiprocessorCount, dev);
        hipFuncSetAttribute((const void*)fwd_kernel, hipFuncAttributeMaxDynamicSharedMemorySize, LDS_BYTES);
        hipOccupancyMaxActiveBlocksPerMultiprocessor(&per_cu, (const void*)fwd_kernel, 512, LDS_BYTES);
        if (per_cu < 1) { fprintf(stderr, "kernel_launch: occupancy query says %d blocks per CU\n", per_cu); per_cu = 1; }
        grid = cus * per_cu;
        (void)hipGetLastError();
    }
    if (grid < 0) return;
    Args a{};
    for (int i = 0; i < 25; ++i) a.in[i] = (const float*)d_in[i];
    a.out = (float*)d_out; a.ws = (unsigned char*)d_ws;
    if (hipMemsetAsync((unsigned char*)d_ws + WS_BAR, 0, BAR_BYTES, stream) != hipSuccess) { fprintf(stderr, "kernel_launch: hipMemsetAsync of the barrier words failed\n"); return; }
#if MK_MULTI_LAUNCH
    for (int ph = 0; ph < NPHASE; ++ph) { a.ph_lo = ph; a.ph_hi = ph + 1; hipLaunchKernelGGL(fwd_kernel, dim3(grid), dim3(512), LDS_BYTES, stream, a); }
#else
    a.ph_lo = 0; a.ph_hi = NPHASE;
    void* args[] = {&a};
    hipError_t e = hipLaunchCooperativeKernel((const void*)fwd_kernel, dim3(grid), dim3(512), args, LDS_BYTES, stream);
    if (e != hipSuccess) fprintf(stderr, "cooperative launch failed: %s (grid %d)\n", hipGetErrorString(e), grid);
#endif
}
```

```cpp
#include <hip/hip_runtime.h>
#include <hip/hip_cooperative_groups.h>
#include <cstdio>
#include <cstdint>
#include <utility>
namespace cg = cooperative_groups;

#ifndef MK_MULTI_LAUNCH
#define MK_MULTI_LAUNCH 0
#endif

#define LAS __attribute__((address_space(3)))
typedef unsigned short bf16_t;
typedef short bf16x8 __attribute__((ext_vector_type(8)));
typedef float f32x4 __attribute__((ext_vector_type(4)));
typedef float f32x16 __attribute__((ext_vector_type(16)));
typedef unsigned u32x4 __attribute__((ext_vector_type(4)));
typedef unsigned u32x2 __attribute__((ext_vector_type(2)));
typedef _Float16 h16x2 __attribute__((ext_vector_type(2)));

constexpr int DM = 1024, NB = 16, SEQ = 2048, CTX = 256, TPB = SEQ + CTX, T = NB * TPB, DEPTH = 4;
constexpr int NH = 8, DQK = 96, QR = 384, KVR = 256, LRU = 512, DFF = 2816, IN_DIM = 1696, IN_PAD = 1792, NMOD = 6 * DM;
constexpr int TLAT = NB * SEQ;
constexpr int NCHUNK = TPB / 64;
constexpr float EPS = 1e-6f;
constexpr float QSCALE = 0.10206207261596577f * 1.4426950408889634f;

constexpr size_t MiB = 1u << 20;
constexpr size_t WS_MOD = 0, WS_SP = 1835008, WS_BAR = 1900544, BAR_BYTES = 16384;
constexpr size_t WS_WT = 2 * MiB;
constexpr size_t WT_IN = 0, WT_UQ = WT_IN + (size_t)IN_PAD * 1024 * 2, WT_KN = WT_UQ + (size_t)768 * 384 * 2, WT_VT = WT_KN + (size_t)512 * 256 * 2,
                 WT_G0 = WT_VT + (size_t)512 * 256 * 2, WT_G1 = WT_G0 + (size_t)1024 * 256 * 2, WT_OUT = WT_G1 + (size_t)1024 * 256 * 2,
                 WT_FFI = WT_OUT + (size_t)1024 * 1024 * 2, WT_FFO = WT_FFI + (size_t)5632 * 1024 * 2, WT_END = WT_FFO + (size_t)1024 * 2816 * 2;
static_assert(WT_END <= 26 * MiB, "weights region");
constexpr size_t WS_FFO_ALT = 28 * MiB;
constexpr size_t WS_RSS = 36 * MiB, WS_RSTD = 40 * MiB;
constexpr size_t WS_XR = 44 * MiB,
                  WS_SUMS = 116 * MiB, WS_G = 121 * MiB, WS_KR = 157 * MiB, WS_UC = 160 * MiB,
                 WS_Q = 196 * MiB, WS_K = 250 * MiB, WS_VT = 304 * MiB, WS_AB = 340 * MiB, WS_U = 340 * MiB, WS_CQ = 376 * MiB, WS_CKV = 403 * MiB,
                 WS_FF = 121 * MiB, WS_END = 484 * MiB;
static_assert(WS_FF + (size_t)T * DFF * 2 <= WS_AB + (size_t)T * 2 * 512 * 4, "ff overlay");
static_assert(WS_AB + (size_t)T * 2 * 512 * 4 <= WS_END, "ab");

constexpr int LDS_BYTES = 131072 + 8192, LDS_BARST = 131072 + 4096;

struct Args { const float* in[25]; float* out; unsigned char* ws; int ph_lo, ph_hi; };

__device__ __forceinline__ unsigned cvt_pk_bf16(float lo, float hi) { unsigned r; asm volatile("v_cvt_pk_bf16_f32 %0, %1, %2" : "=v"(r) : "v"(lo), "v"(hi)); return r; }
__device__ __forceinline__ float bf_lo(unsigned u) { return __uint_as_float(u << 16); }
__device__ __forceinline__ float bf_hi(unsigned u) { return __uint_as_float(u & 0xffff0000u); }
__device__ __forceinline__ float bf1(bf16_t u) { return __uint_as_float((unsigned)u << 16); }
__device__ __forceinline__ bf16_t f2bf(float f) { return (bf16_t)(cvt_pk_bf16(f, 0.f) & 0xffffu); }
__device__ __forceinline__ float wave_sum(float v) {
#pragma unroll
    for (int o = 1; o < 64; o <<= 1) v += __shfl_xor(v, o);
    return v;
}
__device__ __forceinline__ float sigmoidf_(float x) { return __builtin_amdgcn_rcpf(1.0f + __expf(-x)); }
__device__ __forceinline__ float gelu_tanh(float x) { const float u = 0.7978845608028654f * (x + 0.044715f * x * x * x); return x * __builtin_amdgcn_rcpf(1.0f + __expf(-2.0f * u)); }
__device__ __forceinline__ unsigned pack_h2(float a, float b) { h16x2 h; h.x = (_Float16)a; h.y = (_Float16)b; return __builtin_bit_cast(unsigned, h); }

namespace pg8 {
constexpr int BM = 256, BK = 64, HALF = 128, HTB = HALF * BK * 2, STAGE_BYTES = 8 * HTB, NXCD = 8, WGM = 8;
__host__ __device__ __forceinline__ int lds_byte(int r, int c) { const int st = (r >> 4) * 2 + (c >> 5), rr = r & 15, cc = c & 31, ob = rr * 64 + cc * 2; return st * 1024 + (ob ^ (((ob >> 9) & 1) << 5)); }
__host__ __device__ __forceinline__ void stage_rc(int b, int& R, int& C) { const int st = b / 1024, sb = b % 1024, swz = sb ^ (((sb >> 9) & 1) << 5); R = (st >> 1) * 16 + swz / 64; C = (st & 1) * 32 + (swz % 64) / 2; }
__host__ __device__ __forceinline__ int perm32(int rho) { const int n = rho >> 4, i = rho & 15; return 8 * (i >> 2) + 4 * n + (i & 3); }

struct Unit { int pm, pn; };
struct Gemm { const bf16_t* A; const bf16_t* Bt; int M, N, K, lda, ldb; };

struct StaticOrder {
    int nM, nN, nwg, G, c, lat_only;
    __device__ void init(int M, int N, int G_, int c_, int lat_only_ = 0) { nM = M / BM; nN = N / BM; nwg = nM * nN; G = G_; c = c_; lat_only = lat_only_; }
    __device__ bool next(int i, Unit& u) const {
        const long L = (long)i * G + c; if (L >= nwg) return false;
        int wgid = (int)L; { const int q = nwg / NXCD, r = nwg % NXCD, xcd = wgid % NXCD, off = wgid / NXCD; wgid = (xcd < r ? xcd * (q + 1) : r * (q + 1) + (xcd - r) * q) + off; }
        const int nig = WGM * nN, gid = wgid / nig, fm = gid * WGM, gsz = (nM - fm) < WGM ? (nM - fm) : WGM;
        u.pm = fm + ((wgid % nig) % gsz); u.pn = (wgid % nig) / gsz; if (lat_only) u.pm = (u.pm >> 3) * 9 + 1 + (u.pm & 7); return true;
    }
};

template <class Epi, bool ALIGN_EPI>
__device__ __forceinline__ void gemm_phase(LAS unsigned char* lds, const Gemm g, const StaticOrder& S, const Epi& E, const int tid_in) {
    int tid = tid_in; asm volatile("" : "+v"(tid));
    const int wid = __builtin_amdgcn_readfirstlane(tid >> 6), lane = tid & 63, wr = wid >> 2, wc = wid & 3, fr = lane & 15, fq = lane >> 4;
    const int K = g.K, nt = K / BK;
    unsigned voffA[2], voffB[2];
#pragma unroll
    for (int i = 0; i < 2; ++i) { int R, C; stage_rc(tid * 16 + i * 8192, R, C); const int Rb = Epi::PERM ? ((R & ~31) + perm32(R & 31)) : R;
        voffA[i] = (unsigned)(R * g.lda + C) * 2u; voffB[i] = (unsigned)(Rb * g.ldb + C) * 2u;
        asm volatile("" : "+v"(voffA[i])); asm volatile("" : "+v"(voffB[i])); }
    const size_t kstep = (size_t)(BK * 2);
    const size_t hstepA = (size_t)HALF * g.lda * 2, hstepB = (size_t)HALF * g.ldb * 2;
    const size_t tstepA = 2 * hstepA, tstepB = 2 * hstepB;
    const unsigned ldsw = (unsigned)wid * 1024u;
    const int aoff = lds_byte(wr * 64 + fr, fq * 8), boff = lds_byte(wc * 32 + fr, fq * 8);
#define PG8_SA(b, h) (((b) * 2 + (h)) * HTB)
#define PG8_SB(b, h) ((4 + (b) * 2 + (h)) * HTB)
#define PG8_STAGE(bufoff, gbase, voff) do { const char* _gb = (const char*)(gbase); asm volatile("" : "+s"(_gb)); _Pragma("unroll") for (int _i = 0; _i < 2; ++_i) \
        __builtin_amdgcn_global_load_lds((const unsigned*)(_gb + (voff)[_i]), (LAS unsigned*)(lds + (bufoff) + ldsw + _i * 8192), 16, 0, 0); } while (0)
#define PG8_LDA(dst, b, h) do { _Pragma("unroll") for (int m = 0; m < 4; ++m) _Pragma("unroll") for (int k = 0; k < 2; ++k) dst[m][k] = *(const LAS bf16x8*)(lds + PG8_SA(b, h) + aoff + m * 2048 + k * 1024); } while (0)
#define PG8_LDB(dst, b, h) do { _Pragma("unroll") for (int n = 0; n < 2; ++n) _Pragma("unroll") for (int k = 0; k < 2; ++k) dst[n][k] = *(const LAS bf16x8*)(lds + PG8_SB(b, h) + boff + n * 2048 + k * 1024); } while (0)
#define PG8_MMA(ai, bj, At, Bt) do { __builtin_amdgcn_s_setprio(1); _Pragma("unroll") for (int m = 0; m < 4; ++m) _Pragma("unroll") for (int n = 0; n < 2; ++n) _Pragma("unroll") for (int k = 0; k < 2; ++k) \
        acc[ai][bj][m][n] = __builtin_amdgcn_mfma_f32_16x16x32_bf16(Bt[n][k], At[m][k], acc[ai][bj][m][n], 0, 0, 0); __builtin_amdgcn_s_setprio(0); } while (0)
#define PG8_WAIT_V(n) asm volatile("s_waitcnt vmcnt(" #n ")" ::: "memory")
#define PG8_WAIT_L(n) asm volatile("s_waitcnt lgkmcnt(" #n ")" ::: "memory")
#define PG8_BAR __builtin_amdgcn_s_barrier()
#define PG8_SCHED __builtin_amdgcn_sched_barrier(0)
    Unit cur, nxt; int ui = 0;
    if (!S.next(0, cur)) return;
    f32x4 acc[2][2][4][2];
#pragma unroll
    for (int a = 0; a < 2; ++a)
#pragma unroll
        for (int b = 0; b < 2; ++b)
#pragma unroll
            for (int m = 0; m < 4; ++m)
#pragma unroll
                for (int n = 0; n < 2; ++n) acc[a][b][m][n] = (f32x4){0.f, 0.f, 0.f, 0.f};
    bf16x8 At[4][2], B0[2][2], B1[2][2];
    const char* cA = (const char*)g.A + (size_t)cur.pm * tstepA; const char* cB = (const char*)g.Bt + (size_t)cur.pn * tstepB;
    PG8_STAGE(PG8_SB(0, 0), cB, voffB); PG8_STAGE(PG8_SB(0, 1), cB + hstepB, voffB); PG8_STAGE(PG8_SA(0, 0), cA, voffA); PG8_STAGE(PG8_SA(0, 1), cA + hstepA, voffA);
    if (wr == 1) PG8_BAR;
    PG8_WAIT_V(2); PG8_BAR;
    PG8_STAGE(PG8_SB(1, 0), cB + kstep, voffB); PG8_STAGE(PG8_SA(1, 0), cA + kstep, voffA); PG8_STAGE(PG8_SB(1, 1), cB + hstepB + kstep, voffB);
    PG8_WAIT_V(6); PG8_BAR;
    for (;;) {
        const bool has_next = S.next(ui + 1, nxt);
        const char* nA = has_next ? (const char*)g.A + (size_t)nxt.pm * tstepA : cA; const char* nB = has_next ? (const char*)g.Bt + (size_t)nxt.pn * tstepB : cB;
        for (int t = 0; t < nt; t += 2) {
            const bool last = (t == nt - 2);
            const char* a1 = cA + (size_t)(t + 1) * kstep;
            const char* a2 = last ? nA : cA + (size_t)(t + 2) * kstep; const char* b2 = last ? nB : cB + (size_t)(t + 2) * kstep;
            const char* a3 = a2 + kstep; const char* b3 = b2 + kstep;
            PG8_LDB(B0, 0, 0); PG8_LDB(B1, 0, 1); PG8_SCHED; PG8_LDA(At, 0, 0); PG8_STAGE(PG8_SA(1, 1), a1 + hstepA, voffA);
            PG8_WAIT_V(8); PG8_WAIT_L(0); PG8_BAR; PG8_MMA(0, 0, At, B0); PG8_MMA(0, 1, At, B1); PG8_BAR; PG8_SCHED;
            PG8_LDA(At, 0, 1); PG8_STAGE(PG8_SB(0, 0), b2, voffB); PG8_STAGE(PG8_SB(0, 1), b2 + hstepB, voffB); PG8_STAGE(PG8_SA(0, 0), a2, voffA);
            PG8_WAIT_V(8); PG8_WAIT_L(0); PG8_BAR; PG8_MMA(1, 0, At, B0); PG8_MMA(1, 1, At, B1); PG8_BAR; PG8_SCHED;
            PG8_LDB(B0, 1, 0); PG8_LDB(B1, 1, 1); PG8_SCHED; PG8_LDA(At, 1, 0); PG8_STAGE(PG8_SA(0, 1), a2 + hstepA, voffA);
            PG8_WAIT_V(8); PG8_WAIT_L(0); PG8_BAR; PG8_MMA(0, 0, At, B0); PG8_MMA(0, 1, At, B1); PG8_BAR; PG8_SCHED;
            PG8_LDA(At, 1, 1); PG8_STAGE(PG8_SB(1, 0), b3, voffB); PG8_STAGE(PG8_SB(1, 1), b3 + hstepB, voffB); PG8_STAGE(PG8_SA(1, 0), a3, voffA);
            PG8_WAIT_V(8); PG8_WAIT_L(0); PG8_BAR; PG8_MMA(1, 0, At, B0); PG8_MMA(1, 1, At, B1); PG8_BAR; PG8_SCHED;
        }
        if constexpr (ALIGN_EPI) { if (wr == 0) PG8_BAR; }
        PG8_SCHED; { int l2; asm volatile("v_mbcnt_lo_u32_b32 %0, -1, 0\n\tv_mbcnt_hi_u32_b32 %0, -1, %0" : "=v"(l2));
          E(acc, cur, wr, wc, l2 & 15, l2 >> 4); } PG8_SCHED;
        if (!has_next) break;
#pragma unroll
        for (int a = 0; a < 2; ++a)
#pragma unroll
            for (int b = 0; b < 2; ++b)
#pragma unroll
                for (int m = 0; m < 4; ++m)
#pragma unroll
                    for (int n = 0; n < 2; ++n) acc[a][b][m][n] = (f32x4){0.f, 0.f, 0.f, 0.f};
        cur = nxt; cA = nA; cB = nB; ++ui;
        if constexpr (ALIGN_EPI) { if (wr == 1) PG8_BAR; }
    }
    PG8_WAIT_V(0);
    if constexpr (!ALIGN_EPI) { if (wr == 0) PG8_BAR; }
    PG8_BAR;
#undef PG8_SA
#undef PG8_SB
#undef PG8_STAGE
#undef PG8_LDA
#undef PG8_LDB
#undef PG8_MMA
#undef PG8_WAIT_V
#undef PG8_WAIT_L
#undef PG8_BAR
#undef PG8_SCHED
}

template <int MODE> struct EpiStore {
    static constexpr bool PERM = true;
    bf16_t* O; int ldc; bf16_t *cq, *ckv, *kr, *u, *g;
    float* rss;
    const float* rs; float inv_n; int colscale;
    __device__ __forceinline__ void operator()(const f32x4 (&acc)[2][2][4][2], const Unit& un, int wr, int wc, int fr, int fq) const {
        const int row0 = un.pm * BM + wr * 64 + fr;
        if (MODE != 1) {
            int c0 = un.pn * BM + wc * 32 + 8 * fq;
            asm volatile("" : "+v"(c0));
            const int pitch = (MODE == 0) ? ldc : 768;
            bf16_t* p = (MODE == 0) ? O + c0 : O + (c0 >> 6) * 96 + (c0 & 63);
            const int bjstep = (MODE == 0) ? HALF : 192;
            f32x4 csc[2][2];
#pragma unroll
            for (int bj = 0; bj < 2; ++bj)
#pragma unroll
                for (int n = 0; n < 2; ++n) { csc[bj][n] = (f32x4){1.f, 1.f, 1.f, 1.f};
                    if (MODE == 0 && colscale) csc[bj][n] = *(const f32x4*)(rs + c0 + bj * HALF + 4 * n); }
            float rrows[2][4];
#pragma unroll
            for (int ai = 0; ai < 2; ++ai)
#pragma unroll
                for (int m = 0; m < 4; ++m) rrows[ai][m] = (rs != nullptr && !colscale) ? rs[row0 + ai * HALF + m * 16] : 1.0f;
#pragma unroll
            for (int ai = 0; ai < 2; ++ai)
#pragma unroll
                for (int m = 0; m < 4; ++m) {
                    bf16_t* rp = p + (size_t)(row0 + ai * HALF + m * 16) * pitch;
                    const float rrow = rrows[ai][m];
#pragma unroll
                    for (int bj = 0; bj < 2; ++bj) {
                        f32x4 v0 = acc[ai][bj][m][0] * rrow, v1 = acc[ai][bj][m][1] * rrow;
                        if (colscale) { v0 = v0 * csc[bj][0]; v1 = v1 * csc[bj][1]; }
                        u32x4 w; w.x = cvt_pk_bf16(v0[0], v0[1]); w.y = cvt_pk_bf16(v0[2], v0[3]); w.z = cvt_pk_bf16(v1[0], v1[1]); w.w = cvt_pk_bf16(v1[2], v1[3]);
                        *(u32x4*)(rp + bj * bjstep) = w;
                    }
                    asm volatile("" ::: "memory");
                }
            return;
        }
#pragma unroll
        for (int bj = 0; bj < 2; ++bj) {
            const int c0 = un.pn * BM + bj * HALF + wc * 32 + 8 * fq;
            bf16_t* p; int pitch;
            if (c0 < 384) { p = cq + c0; pitch = 384; }
            else if (c0 < 640) { p = ckv + (c0 - 384); pitch = 256; }
            else if (c0 < 672) { p = kr + (c0 - 640); pitch = 32; }
            else if (c0 < 1184) { p = u + (c0 - 672); pitch = 512; }
            else if (c0 < 1696) { p = g + (c0 - 1184); pitch = 512; }
            else { p = nullptr; pitch = 0; }
            if (p == nullptr) continue;
            const int grp = (c0 < 640) ? (c0 >> 5) : -1;
#pragma unroll
            for (int ai = 0; ai < 2; ++ai)
#pragma unroll
                for (int m = 0; m < 4; ++m) {
                    const f32x4 v0 = acc[ai][bj][m][0], v1 = acc[ai][bj][m][1];
                    u32x4 w; w.x = cvt_pk_bf16(v0[0], v0[1]); w.y = cvt_pk_bf16(v0[2], v0[3]); w.z = cvt_pk_bf16(v1[0], v1[1]); w.w = cvt_pk_bf16(v1[2], v1[3]);
                    *(u32x4*)(p + (size_t)(row0 + ai * HALF + m * 16) * pitch) = w;
                    if (grp >= 0) {
                        float sq = (v0[0] * v0[0] + v0[1] * v0[1]) + (v0[2] * v0[2] + v0[3] * v0[3]) + (v1[0] * v1[0] + v1[1] * v1[1]) + (v1[2] * v1[2] + v1[3] * v1[3]);
                        sq += __shfl_xor(sq, 16); sq += __shfl_xor(sq, 32);
                        if (fq == 0) rss[(size_t)(row0 + ai * HALF + m * 16) * 20 + grp] = sq;
                    }
                }
        }
    }
};
struct EpiGates {
    static constexpr bool PERM = false;
    const float *ba, *bx, *sp8;
    const bf16_t* uc; unsigned* ab;
    __device__ __forceinline__ void operator()(const f32x4 (&acc)[2][2][4][2], const Unit& un, int wr, int wc, int fr, int fq) const {
        const int row0 = un.pm * BM + wr * 64 + fr, ch = 64 * un.pn + 16 * wc + 4 * fq;
        u32x2 uu[2][4];
#pragma unroll
        for (int ai = 0; ai < 2; ++ai)
#pragma unroll
            for (int m = 0; m < 4; ++m) uu[ai][m] = *(const u32x2*)(uc + (size_t)(row0 + ai * HALF + m * 16) * 512 + ch);
        f32x4 ba4_[2], bx4_[2], sp_[2];
#pragma unroll
        for (int d = 0; d < 2; ++d) { ba4_[d] = *(const f32x4*)(ba + d * 512 + ch); bx4_[d] = *(const f32x4*)(bx + d * 512 + ch); sp_[d] = *(const f32x4*)(sp8 + d * 512 + ch); }
#pragma unroll
        for (int bj = 0; bj < 2; ++bj) {
            const int d = bj;
            const f32x4 ba4 = ba4_[d], bx4 = bx4_[d], sp = sp_[d];
#pragma unroll
            for (int ai = 0; ai < 2; ++ai)
#pragma unroll
                for (int m = 0; m < 4; ++m) {
                    const int row = row0 + ai * HALF + m * 16;
                    const float uv[4] = {bf_lo(uu[ai][m].x), bf_hi(uu[ai][m].x), bf_lo(uu[ai][m].y), bf_hi(uu[ai][m].y)};
                    unsigned w[4];
#pragma unroll
                    for (int e = 0; e < 4; ++e) {
                        const float r = sigmoidf_(acc[ai][bj][m][0][e] + ba4[e]), ig = sigmoidf_(acc[ai][bj][m][1][e] + bx4[e]);
                        const float la = -r * sp[e];
                        const float bb = __builtin_amdgcn_sqrtf(fmaxf(1.0f - __expf(2.0f * la), 0.f)) * (ig * uv[e]);
                        w[e] = pack_h2(la, bb);
                    }
                    *(u32x4*)(ab + ((size_t)row * 2 + d) * 512 + ch) = (u32x4){w[0], w[1], w[2], w[3]};
                }
        }
    }
};
template <bool FINAL> struct EpiResid {
    static constexpr bool PERM = true;
    const float* gate;
    bf16_t* xr; float* out;
    __device__ __forceinline__ void operator()(const f32x4 (&acc)[2][2][4][2], const Unit& un, int wr, int wc, int fr, int fq) const {
        const int b = un.pm / 9, jj = un.pm % 9;
        const float* gp = gate + (size_t)(jj == 0 ? 16 : b) * NMOD;
        const int row0 = un.pm * BM + wr * 64 + fr, col0 = un.pn * BM + wc * 32 + 8 * fq;
        f32x4 g4[2][2];
#pragma unroll
        for (int bj = 0; bj < 2; ++bj)
#pragma unroll
            for (int n = 0; n < 2; ++n) g4[bj][n] = *(const f32x4*)(gp + col0 + bj * HALF + n * 4);
        u32x4 xin[2][4][2];
#pragma unroll
        for (int ai = 0; ai < 2; ++ai)
#pragma unroll
            for (int m = 0; m < 4; ++m)
#pragma unroll
                for (int bj = 0; bj < 2; ++bj) xin[ai][m][bj] = *(const u32x4*)(xr + (size_t)(row0 + ai * HALF + m * 16) * DM + col0 + bj * HALF);
#pragma unroll
        for (int ai = 0; ai < 2; ++ai) {
#pragma unroll
            for (int m = 0; m < 4; ++m) {
                const int row = row0 + ai * HALF + m * 16;
                bf16_t* xp = xr + (size_t)row * DM + col0;
#pragma unroll
                for (int bj = 0; bj < 2; ++bj) {
                    const u32x4 xi = xin[ai][m][bj];
                    const f32x4 x0 = (f32x4){bf_lo(xi.x), bf_hi(xi.x), bf_lo(xi.y), bf_hi(xi.y)}, x1 = (f32x4){bf_lo(xi.z), bf_hi(xi.z), bf_lo(xi.w), bf_hi(xi.w)};
                    const f32x4 y0 = x0 + g4[bj][0] * acc[ai][bj][m][0], y1 = x1 + g4[bj][1] * acc[ai][bj][m][1];
                    if (FINAL) {
                        float* op = out + ((size_t)b * SEQ + (size_t)(jj - 1) * 256 + (row - un.pm * BM)) * DM + col0 + bj * HALF;
                        *(f32x4*)op = y0; *(f32x4*)(op + 4) = y1;
                    } else {
                        u32x4 w; w.x = cvt_pk_bf16(y0[0], y0[1]); w.y = cvt_pk_bf16(y0[2], y0[3]); w.z = cvt_pk_bf16(y1[0], y1[1]); w.w = cvt_pk_bf16(y1[2], y1[3]);
                        *(u32x4*)(xp + bj * HALF) = w;
                    }
                }
            }
            asm volatile("" ::: "memory");
        }
    }
};
struct EpiSwiglu {
    static constexpr bool PERM = false;
    bf16_t* ff;
    __device__ __forceinline__ void operator()(const f32x4 (&acc)[2][2][4][2], const Unit& un, int wr, int wc, int fr, int fq) const {
        const int row0 = un.pm * BM + wr * 64 + fr;
#pragma unroll
        for (int bj = 0; bj < 2; ++bj) {
            const int j0 = (un.pn * 8 + bj * 4 + wc) * 16 + 4 * fq;
#pragma unroll
            for (int ai = 0; ai < 2; ++ai)
#pragma unroll
                for (int m = 0; m < 4; ++m) {
                    const f32x4 gt = acc[ai][bj][m][0], up = acc[ai][bj][m][1];
                    float v[4];
#pragma unroll
                    for (int e = 0; e < 4; ++e) v[e] = gt[e] * sigmoidf_(gt[e]) * up[e];
                    u32x2 w; w.x = cvt_pk_bf16(v[0], v[1]); w.y = cvt_pk_bf16(v[2], v[3]);
                    *(u32x2*)(ff + (size_t)(row0 + ai * HALF + m * 16) * DFF + j0) = w;
                }
        }
    }
};
}

__device__ __forceinline__ void gates_phase(LAS unsigned char* lds, const bf16_t* uc, const bf16_t* wg, const pg8::EpiGates& E, float* sums, const int tid_in, const int bid, const int G) {
    int tid = tid_in; asm volatile("" : "+v"(tid));
    const int wid = __builtin_amdgcn_readfirstlane(tid >> 6), lane = tid & 63, wr = wid >> 2, wc = wid & 3, fr = lane & 15, fq = lane >> 4;
    constexpr int P = 144, NU = (T / 256) * 8;
    LAS unsigned char* As = lds; LAS unsigned char* Bs = lds + 256 * P;
    const int lrow = tid >> 3, c8 = tid & 7;
    u32x4 ra[4], rb[4];
    int unit = bid;
    if (unit < NU) {
        const int pm = unit >> 3, nb = unit & 7;
#pragma unroll
        for (int i = 0; i < 4; ++i) { ra[i] = *(const u32x4*)(uc + (size_t)(pm * 256 + 64 * i + lrow) * LRU + 64 * nb + 8 * c8); rb[i] = *(const u32x4*)(wg + (size_t)(nb * 256 + 64 * i + lrow) * 64 + 8 * c8); }
    }
    while (unit < NU) {
        const int pm = unit >> 3, nb = unit & 7;
#pragma unroll
        for (int i = 0; i < 4; ++i) { *(LAS u32x4*)(As + (64 * i + lrow) * P + 16 * c8) = ra[i]; *(LAS u32x4*)(Bs + (64 * i + lrow) * P + 16 * c8) = rb[i]; }
        __syncthreads();
        const int nxt = unit + G;
        if (nxt < NU) {
            const int pm2 = nxt >> 3, nb2 = nxt & 7;
#pragma unroll
            for (int i = 0; i < 4; ++i) { ra[i] = *(const u32x4*)(uc + (size_t)(pm2 * 256 + 64 * i + lrow) * LRU + 64 * nb2 + 8 * c8); rb[i] = *(const u32x4*)(wg + (size_t)(nb2 * 256 + 64 * i + lrow) * 64 + 8 * c8); }
        }
        f32x4 acc[2][2][4][2];
#pragma unroll
        for (int ai = 0; ai < 2; ++ai) {
            bf16x8 At[4][2];
#pragma unroll
            for (int m = 0; m < 4; ++m)
#pragma unroll
                for (int k = 0; k < 2; ++k) At[m][k] = *(const LAS bf16x8*)(As + (128 * ai + 64 * wr + 16 * m + fr) * P + 64 * k + 16 * fq);
#pragma unroll
            for (int bj = 0; bj < 2; ++bj) {
                bf16x8 Bf[2][2];
#pragma unroll
                for (int n = 0; n < 2; ++n)
#pragma unroll
                    for (int k = 0; k < 2; ++k) Bf[n][k] = *(const LAS bf16x8*)(Bs + (128 * bj + 32 * wc + 16 * n + fr) * P + 64 * k + 16 * fq);
#pragma unroll
                for (int m = 0; m < 4; ++m)
#pragma unroll
                    for (int n = 0; n < 2; ++n) {
                        f32x4 c = (f32x4){0.f, 0.f, 0.f, 0.f};
#pragma unroll
                        for (int k = 0; k < 2; ++k) c = __builtin_amdgcn_mfma_f32_16x16x32_bf16(Bf[n][k], At[m][k], c, 0, 0, 0);
                        acc[ai][bj][m][n] = c;
                    }
            }
        }
        __syncthreads();
        const pg8::Unit un{pm, nb};
        E(acc, un, wr, wc, fr, fq);
        asm volatile("s_waitcnt vmcnt(0)" ::: "memory"); __syncthreads();
        {
            const int cl = wid >> 1, d = wid & 1, ch = 64 * nb + lane, t0 = pm * 256 + cl * 64;
            const unsigned* abp = E.ab + ((size_t)t0 * 2 + d) * 512 + ch;
            float hs = 0.f, sl = 0.f;
            unsigned av[64];
#pragma unroll
            for (int i = 0; i < 64; ++i) av[i] = abp[(size_t)i * 1024];
            if (d == 0) {
#pragma unroll
                for (int i = 0; i < 64; ++i) { const h16x2 v = __builtin_bit_cast(h16x2, av[i]); const float la = (float)v.x; hs = __expf(la) * hs + (float)v.y; sl += la; }
            } else {
#pragma unroll
                for (int i = 63; i >= 0; --i) { const h16x2 v = __builtin_bit_cast(h16x2, av[i]); const float la = (float)v.x; hs = __expf(la) * hs + (float)v.y; sl += la; }
            }
            const int bc = (pm / 9) * NCHUNK + (pm % 9) * 4 + cl;
            *(float2*)(sums + (((size_t)bc * 2 + d) * 512 + ch) * 2) = make_float2(sl, hs);
        }
        unit = nxt;
    }
}

struct WSrc { const float* p; int ld, klo, khi; const float* kg; };
__device__ __forceinline__ WSrc wsrc(const Args& a, int l, int mat, int n) {
    WSrc s; s.p = nullptr; s.ld = 0; s.klo = 0; s.khi = 1 << 30; s.kg = nullptr;
    switch (mat) {
        case 0: if (n < IN_DIM) { s.p = a.in[8] + (size_t)l * DM * IN_DIM + n; s.ld = IN_DIM; } break;
        case 1: s.p = a.in[10] + (size_t)l * QR * 768 + n; s.ld = 768; s.kg = a.in[9] + (size_t)l * QR; break;
        case 2: s.p = a.in[12] + (size_t)l * KVR * 1024 + (n >> 6) * 128 + (n & 63); s.ld = 1024; s.kg = a.in[11] + (size_t)l * KVR; break;
        case 3: s.p = a.in[12] + (size_t)l * KVR * 1024 + (n >> 6) * 128 + 64 + (n & 63); s.ld = 1024; s.kg = a.in[11] + (size_t)l * KVR; break;
        case 4: case 5: {
            const int nb = n >> 8, c = n & 255, d = c >> 7, chg = (c >> 5) & 3, kind = (c >> 4) & 1, c16 = c & 15, e = 16 * chg + c16;
            const float* w = kind ? a.in[19] : a.in[17];
            s.p = w + ((((size_t)l * 2 + d) * 8 + nb) * 64) * 64 + e; s.ld = 64; } break;
        case 6: s.p = a.in[22] + (size_t)l * DM * DM + n; s.ld = DM; break;
        case 7: { const int g32 = n >> 5, kind = (n >> 4) & 1, c16 = n & 15, jc = g32 * 16 + c16; s.p = a.in[23] + (size_t)l * DM * 2 * DFF + (kind ? DFF + jc : jc); s.ld = 2 * DFF; } break;
        default: s.p = a.in[24] + (size_t)l * DFF * DM + n; s.ld = DM; break;
    }
    return s;
}
__device__ __forceinline__ void wt_item(const Args& a, int l, int mat, int K, int N, bf16_t* WT, LAS float* scr, int item, int lane) {
    const int nblk = N / 32, kb = item / nblk, nb = item % nblk, k0 = 64 * kb, n0 = 32 * nb;
    const int n4 = (lane & 7) * 4, kr = lane >> 3;
    const WSrc s = wsrc(a, l, mat, n0 + n4);
    f32x4 v[8];
#pragma unroll
    for (int i = 0; i < 8; ++i) { const int k = k0 + 8 * i + kr;
        v[i] = (f32x4){0.f, 0.f, 0.f, 0.f}; if (s.p != nullptr && k >= s.klo && k < s.khi) { v[i] = *(const f32x4*)(s.p + (size_t)(k - s.klo) * s.ld); if (s.kg != nullptr) v[i] = v[i] * s.kg[k]; } }
#pragma unroll
    for (int i = 0; i < 8; ++i) { LAS float* d = scr + (8 * i + kr) * 33 + n4; d[0] = v[i][0]; d[1] = v[i][1]; d[2] = v[i][2]; d[3] = v[i][3]; }
    asm volatile("s_waitcnt lgkmcnt(0)" ::: "memory");
    const int c = lane & 7;
#pragma unroll
    for (int j = 0; j < 4; ++j) { const int n = (lane >> 3) + 8 * j; const LAS float* sp = scr + (8 * c) * 33 + n;
        u32x4 o; o.x = cvt_pk_bf16(sp[0 * 33], sp[1 * 33]); o.y = cvt_pk_bf16(sp[2 * 33], sp[3 * 33]); o.z = cvt_pk_bf16(sp[4 * 33], sp[5 * 33]); o.w = cvt_pk_bf16(sp[6 * 33], sp[7 * 33]);
        *(u32x4*)(WT + (size_t)(n0 + n) * K + k0 + 8 * c) = o; }
    asm volatile("s_waitcnt lgkmcnt(0)" ::: "memory");
}
__device__ __forceinline__ void convert_weights(const Args& a, int l, LAS unsigned char* lds, int gw, int NGW, int wid, int lane) {
    LAS float* scr = (LAS float*)(lds + wid * 8704);
    bf16_t* wt = (bf16_t*)(a.ws + WS_WT);
    const size_t ffo = (l & 1) ? (WS_FFO_ALT - WS_WT) : WT_FFO;
    const int Ks[9] = {1024, 384, 256, 256, 64, 64, 1024, 1024, 2816};
    const int Ns[9] = {IN_PAD, 768, 512, 512, 2048, 0, 1024, 5632, 1024};
    const size_t offs[9] = {WT_IN, WT_UQ, WT_KN, WT_VT, WT_G0, WT_G1, WT_OUT, WT_FFI, ffo};
#pragma unroll
    for (int mat = 0; mat < 9; ++mat) {
        const int K = Ks[mat], N = Ns[mat], items = (K / 64) * (N / 32);
        for (int it = gw; it < items; it += NGW) wt_item(a, l, mat, K, N, wt + offs[mat] / 2, scr, it, lane);
    }
}

__device__ __forceinline__ void mod_phase(const Args& a, LAS unsigned char* lds, const int tid, const int ubeg, const int uend, const int first, const int stride) {
    LAS float* s = (LAS float*)lds;
    LAS float* red = (LAS float*)(lds + 17 * 1024 * 4);
    for (int i = tid; i < 17 * 1024; i += 512) { const int r = i >> 10, k = i & 1023; const float v = r < 16 ? a.in[1][r * 1024 + k] : a.in[3][k]; s[i] = v * sigmoidf_(v); }
    __syncthreads();
    float* mod = (float*)(a.ws + WS_MOD);
    const int ks = tid >> 6, cl = tid & 63;
    for (int unit = ubeg + first; unit < uend; unit += stride) {
        const int l = unit / 96, n0 = (unit % 96) * 64;
        const float* w = a.in[4] + (size_t)l * DM * NMOD + n0 + cl;
        float acc[17];
#pragma unroll
        for (int r = 0; r < 17; ++r) acc[r] = 0.f;
        for (int kk = 0; kk < 128; kk += 8) {
            const int k = ks * 128 + kk;
            float wv[8];
#pragma unroll
            for (int j = 0; j < 8; ++j) wv[j] = w[(size_t)(k + j) * NMOD];
#pragma unroll
            for (int j4 = 0; j4 < 2; ++j4)
#pragma unroll
                for (int r = 0; r < 17; ++r) { const f32x4 sv = *(const LAS f32x4*)(s + r * 1024 + k + 4 * j4); acc[r] += sv[0] * wv[4 * j4] + sv[1] * wv[4 * j4 + 1] + sv[2] * wv[4 * j4 + 2] + sv[3] * wv[4 * j4 + 3]; }
        }
#pragma unroll
        for (int r = 0; r < 17; ++r) red[(ks * 17 + r) * 64 + cl] = acc[r];
        __syncthreads();
        for (int i = tid; i < 17 * 64; i += 512) { const int r = i >> 6, c = i & 63; float v = a.in[5][(size_t)l * NMOD + n0 + c];
#pragma unroll
            for (int q = 0; q < 8; ++q) v += red[(q * 17 + r) * 64 + c];
            mod[((size_t)l * 17 + r) * NMOD + n0 + c] = v; }
        __syncthreads();
    }
}

__device__ __forceinline__ void norm_rows(int t_begin, int t_end, const bf16_t* xr, const float* modl, int sh_off, int sc_off, const float* gain, bf16_t* H, int lane, float* rss_zero) {
    if (rss_zero != nullptr) { for (int t = t_begin + lane; t < t_end; t += 64) { rss_zero[t] = 0.f; rss_zero[T + t] = 0.f; } }
    f32x4 g[4];
#pragma unroll
    for (int q = 0; q < 4; ++q) g[q] = *(const f32x4*)(gain + 8 * lane + 512 * (q >> 1) + 4 * (q & 1));
    constexpr int NT = 3;
    for (int t0 = t_begin; t0 < t_end; t0 += NT) {
        u32x4 xi[NT][2]; f32x4 sh[NT][4], sc[NT][4];
#pragma unroll
        for (int r = 0; r < NT; ++r) {
            const int t = (t0 + r < t_end) ? t0 + r : t0;
            const int b = t / TPB, j = t % TPB;
            const float* mp = modl + (size_t)(j < CTX ? 16 : b) * NMOD;
#pragma unroll
            for (int q = 0; q < 2; ++q) xi[r][q] = *(const u32x4*)(xr + (size_t)t * DM + 8 * lane + 512 * q);
#pragma unroll
            for (int q = 0; q < 4; ++q) { const int k = 8 * lane + 512 * (q >> 1) + 4 * (q & 1); sh[r][q] = *(const f32x4*)(mp + sh_off + k); sc[r][q] = *(const f32x4*)(mp + sc_off + k); }
        }
#pragma unroll
        for (int r = 0; r < NT; ++r) {
            if (t0 + r >= t_end) break;
            f32x4 v[4];
#pragma unroll
            for (int q = 0; q < 2; ++q) { const u32x4 w = xi[r][q]; v[2 * q] = (f32x4){bf_lo(w.x), bf_hi(w.x), bf_lo(w.y), bf_hi(w.y)}; v[2 * q + 1] = (f32x4){bf_lo(w.z), bf_hi(w.z), bf_lo(w.w), bf_hi(w.w)}; }
            float ss = 0.f;
#pragma unroll
            for (int q = 0; q < 4; ++q) ss += v[q][0] * v[q][0] + v[q][1] * v[q][1] + v[q][2] * v[q][2] + v[q][3] * v[q][3];
            const float rstd = rsqrtf(wave_sum(ss) * (1.0f / DM) + EPS);
#pragma unroll
            for (int q = 0; q < 2; ++q) {
                const f32x4 y0 = (v[2 * q] * rstd * g[2 * q]) * (sc[r][2 * q] + 1.0f) + sh[r][2 * q], y1 = (v[2 * q + 1] * rstd * g[2 * q + 1]) * (sc[r][2 * q + 1] + 1.0f) + sh[r][2 * q + 1];
                u32x4 w; w.x = cvt_pk_bf16(y0[0], y0[1]); w.y = cvt_pk_bf16(y0[2], y0[3]); w.z = cvt_pk_bf16(y1[0], y1[1]); w.w = cvt_pk_bf16(y1[2], y1[3]);
                *(u32x4*)(H + (size_t)(t0 + r) * DM + 8 * lane + 512 * q) = w;
            }
        }
    }
}
__device__ __forceinline__ void load_residual(const float* x, const float* ctx, bf16_t* xr, int t_begin, int t_end, int lane) {
    for (int t0 = t_begin; t0 < t_end; t0 += 2) {
        f32x4 v[2][4];
#pragma unroll
        for (int r = 0; r < 2; ++r) {
            const int t = (t0 + r < t_end) ? t0 + r : t0; const int b = t / TPB, j = t % TPB;
            const float* src = (j < CTX) ? ctx + ((size_t)b * CTX + j) * DM : x + ((size_t)b * SEQ + (j - CTX)) * DM;
#pragma unroll
            for (int q = 0; q < 4; ++q) v[r][q] = *(const f32x4*)(src + 8 * lane + 512 * (q >> 1) + 4 * (q & 1));
        }
#pragma unroll
        for (int r = 0; r < 2; ++r) {
            if (t0 + r >= t_end) break;
#pragma unroll
            for (int q = 0; q < 2; ++q) { const f32x4 a0 = v[r][2 * q], a1 = v[r][2 * q + 1];
                u32x4 w; w.x = cvt_pk_bf16(a0[0], a0[1]); w.y = cvt_pk_bf16(a0[2], a0[3]); w.z = cvt_pk_bf16(a1[0], a1[1]); w.w = cvt_pk_bf16(a1[2], a1[3]);
                *(u32x4*)(xr + (size_t)(t0 + r) * DM + 8 * lane + 512 * q) = w; }
        }
    }
}
__device__ __forceinline__ void norm_rows_in(int t_begin, int t_end, const float* x, const float* ctx, bf16_t* xr, const float* modl, int sh_off, int sc_off, const float* gain, bf16_t* H, int lane) {
    f32x4 g[4];
#pragma unroll
    for (int q = 0; q < 4; ++q) g[q] = *(const f32x4*)(gain + 8 * lane + 512 * (q >> 1) + 4 * (q & 1));
    for (int t0 = t_begin; t0 < t_end; t0 += 2) {
        f32x4 vin[2][4], sh[2][4], sc[2][4];
#pragma unroll
        for (int r = 0; r < 2; ++r) {
            const int t = (t0 + r < t_end) ? t0 + r : t0; const int b = t / TPB, j = t % TPB;
            const float* src = (j < CTX) ? ctx + ((size_t)b * CTX + j) * DM : x + ((size_t)b * SEQ + (j - CTX)) * DM;
            const float* mp = modl + (size_t)(j < CTX ? 16 : b) * NMOD;
#pragma unroll
            for (int q = 0; q < 4; ++q) { const int k = 8 * lane + 512 * (q >> 1) + 4 * (q & 1); vin[r][q] = *(const f32x4*)(src + k); sh[r][q] = *(const f32x4*)(mp + sh_off + k); sc[r][q] = *(const f32x4*)(mp + sc_off + k); }
        }
#pragma unroll
        for (int r = 0; r < 2; ++r) {
            if (t0 + r >= t_end) break;
            f32x4 v[4]; float ss = 0.f;
#pragma unroll
            for (int q = 0; q < 2; ++q) { const f32x4 a0 = vin[r][2 * q], a1 = vin[r][2 * q + 1];
                u32x4 w; w.x = cvt_pk_bf16(a0[0], a0[1]); w.y = cvt_pk_bf16(a0[2], a0[3]); w.z = cvt_pk_bf16(a1[0], a1[1]); w.w = cvt_pk_bf16(a1[2], a1[3]);
                *(u32x4*)(xr + (size_t)(t0 + r) * DM + 8 * lane + 512 * q) = w;
                v[2 * q] = (f32x4){bf_lo(w.x), bf_hi(w.x), bf_lo(w.y), bf_hi(w.y)}; v[2 * q + 1] = (f32x4){bf_lo(w.z), bf_hi(w.z), bf_lo(w.w), bf_hi(w.w)}; }
#pragma unroll
            for (int q = 0; q < 4; ++q) ss += v[q][0] * v[q][0] + v[q][1] * v[q][1] + v[q][2] * v[q][2] + v[q][3] * v[q][3];
            const float rstd = rsqrtf(wave_sum(ss) * (1.0f / DM) + EPS);
#pragma unroll
            for (int q = 0; q < 2; ++q) {
                const f32x4 y0 = (v[2 * q] * rstd * g[2 * q]) * (sc[r][2 * q] + 1.0f) + sh[r][2 * q], y1 = (v[2 * q + 1] * rstd * g[2 * q + 1]) * (sc[r][2 * q + 1] + 1.0f) + sh[r][2 * q + 1];
                u32x4 w; w.x = cvt_pk_bf16(y0[0], y0[1]); w.y = cvt_pk_bf16(y0[2], y0[3]); w.z = cvt_pk_bf16(y1[0], y1[1]); w.w = cvt_pk_bf16(y1[2], y1[3]);
                *(u32x4*)(H + (size_t)(t0 + r) * DM + 8 * lane + 512 * q) = w;
            }
        }
    }
}
__device__ __forceinline__ void mid_rows(const Args& a, int l, int t_begin, int t_end, int lane) {
    const bf16_t* u = (const bf16_t*)(a.ws + WS_U); bf16_t* ucb = (bf16_t*)(a.ws + WS_UC);
    const float* rssp = (const float*)(a.ws + WS_RSS); float* rstd = (float*)(a.ws + WS_RSTD);
    const int ch = 8 * lane;
    float cw[4][8], cb[8];
#pragma unroll
    for (int q = 0; q < 4; ++q)
#pragma unroll
        for (int i = 0; i < 8; ++i) cw[q][i] = a.in[15][((size_t)l * 4 + q) * LRU + ch + i];
#pragma unroll
    for (int i = 0; i < 8; ++i) cb[i] = a.in[16][(size_t)l * LRU + ch + i];
    for (int t0 = t_begin; t0 < t_end; t0 += 2) {
        u32x4 uu[2][4];
#pragma unroll
        for (int r = 0; r < 2; ++r) {
            const int t = (t0 + r < t_end) ? t0 + r : t0;
            const int j = t % TPB; const int tl = (j < CTX) ? j : j - CTX, len = (j < CTX) ? CTX : SEQ;
#pragma unroll
            for (int q = 0; q < 4; ++q) { const int tt = tl - 1 + q; uu[r][q] = (tt >= 0 && tt < len) ? *(const u32x4*)(u + (size_t)(t - 1 + q) * LRU + ch) : (u32x4){0u, 0u, 0u, 0u}; }
        }
#pragma unroll
        for (int r = 0; r < 2; ++r) {
            if (t0 + r >= t_end) break;
            const int t = t0 + r;
            {
                const float pv = (lane < 20) ? rssp[(size_t)t * 20 + lane] : 0.f;
                const float sq = wave_sum(lane < 12 ? pv : 0.f), skv = wave_sum(lane >= 12 ? pv : 0.f);
                if (lane == 0) { rstd[t] = rsqrtf(sq * (1.0f / QR) + EPS); rstd[T + t] = rsqrtf(skv * (1.0f / KVR) + EPS); }
            }
            float o[8];
#pragma unroll
            for (int i = 0; i < 8; ++i) o[i] = cb[i];
#pragma unroll
            for (int q = 0; q < 4; ++q) { const u32x4 w = uu[r][q];
                o[0] += bf_lo(w.x) * cw[q][0]; o[1] += bf_hi(w.x) * cw[q][1]; o[2] += bf_lo(w.y) * cw[q][2]; o[3] += bf_hi(w.y) * cw[q][3];
                o[4] += bf_lo(w.z) * cw[q][4]; o[5] += bf_hi(w.z) * cw[q][5]; o[6] += bf_lo(w.w) * cw[q][6]; o[7] += bf_hi(w.w) * cw[q][7]; }
            u32x4 rr; rr.x = cvt_pk_bf16(o[0], o[1]); rr.y = cvt_pk_bf16(o[2], o[3]); rr.z = cvt_pk_bf16(o[4], o[5]); rr.w = cvt_pk_bf16(o[6], o[7]);
            *(u32x4*)(ucb + (size_t)t * LRU + ch) = rr;
        }
    }
}
__device__ __forceinline__ void fin_rows(const Args& a, int l, int t_begin, int t_end, int lane) {
    const int h = lane >> 3, sub = lane & 7; const bool rl = sub < 4;
    float gk0[8], gk1[8];
    { const float* gk = a.in[14] + (size_t)l * DQK;
#pragma unroll
      for (int i = 0; i < 8; ++i) { gk0[i] = gk[8 * sub + i]; gk1[i] = rl ? gk[64 + 8 * sub + i] : 0.f; } }
    float inv[8];
#pragma unroll
    for (int i = 0; i < 8; ++i) inv[i] = __builtin_amdgcn_exp2f(-(float)i * (13.287712379549449f / 8.0f));
    const float sgn = (sub & 1) ? 1.0f : -1.0f;
    bf16_t* Kb = (bf16_t*)(a.ws + WS_K); const bf16_t* KR = (const bf16_t*)(a.ws + WS_KR);
    constexpr int NT = 3;
    for (int t0 = t_begin; t0 < t_end; t0 += NT) {
        u32x4 ka[NT], kr4[NT];
#pragma unroll
        for (int r = 0; r < NT; ++r) { const int t = (t0 + r < t_end) ? t0 + r : t0;
            ka[r] = *(const u32x4*)(Kb + (size_t)t * 768 + h * 96 + 8 * sub); kr4[r] = rl ? *(const u32x4*)(KR + (size_t)t * 32 + 8 * sub) : (u32x4){0u, 0u, 0u, 0u}; }
#pragma unroll
        for (int r = 0; r < NT; ++r) {
            if (t0 + r >= t_end) break;
            const int t = t0 + r, j = t % TPB; const bool lat = j >= CTX; const int tl = j - CTX;
            const float pos = lat ? (float)((sub < 2) ? (tl >> 6) : (tl & 63)) : 0.f;
            const u32x4 wa = ka[r], wr = kr4[r];
            float x[8] = {bf_lo(wa.x), bf_hi(wa.x), bf_lo(wa.y), bf_hi(wa.y), bf_lo(wa.z), bf_hi(wa.z), bf_lo(wa.w), bf_hi(wa.w)};
            float y[8] = {bf_lo(wr.x), bf_hi(wr.x), bf_lo(wr.y), bf_hi(wr.y), bf_lo(wr.z), bf_hi(wr.z), bf_lo(wr.w), bf_hi(wr.w)};
            float ss = 0.f;
#pragma unroll
            for (int i = 0; i < 8; ++i) ss += x[i] * x[i] + y[i] * y[i];
            ss += __shfl_xor(ss, 1); ss += __shfl_xor(ss, 2); ss += __shfl_xor(ss, 4);
            const float rstd = rsqrtf(ss * (1.0f / DQK) + EPS);
#pragma unroll
            for (int i = 0; i < 8; ++i) { x[i] *= rstd * gk0[i]; y[i] *= rstd * gk1[i]; }
            float o[8];
#pragma unroll
            for (int i = 0; i < 8; ++i) { const float ang = pos * inv[i]; const float py = __shfl_xor(y[i], 1); o[i] = y[i] * __cosf(ang) + py * (__sinf(ang) * sgn); }
            bf16_t* base = Kb + (size_t)t * 768 + h * 96;
            u32x4 w; w.x = cvt_pk_bf16(x[0], x[1]); w.y = cvt_pk_bf16(x[2], x[3]); w.z = cvt_pk_bf16(x[4], x[5]); w.w = cvt_pk_bf16(x[6], x[7]);
            *(u32x4*)(base + 8 * sub) = w;
            if (rl) { u32x4 rr; rr.x = cvt_pk_bf16(o[0], o[1]); rr.y = cvt_pk_bf16(o[2], o[3]); rr.z = cvt_pk_bf16(o[4], o[5]); rr.w = cvt_pk_bf16(o[6], o[7]);
                      *(u32x4*)(base + 64 + 8 * sub) = rr; }
        }
    }
}

constexpr float SSHIFT = 8.0f;
constexpr int KPITCH = 208, VPITCH = 144, KBUF = 64 * KPITCH, VBUF = 64 * VPITCH;
__device__ __forceinline__ void attn_unit(LAS unsigned char* lds, const bf16_t* Q, const bf16_t* Kb, const bf16_t* VT, bf16_t* cat, const float* qgain, const bool rope_on, int h, int qrow0, int krow0, int nk, const int tid) {
    const int wid = tid >> 6, lane = tid & 63, l32 = lane & 31, hi = lane >> 5;
    const bf16_t* qp = Q + (size_t)(qrow0 + wid * 32 + l32) * 768 + h * 96 + 8 * hi;
    bf16x8 qf[6];
    {
        u32x4 raw[6]; float ss = 0.f;
#pragma unroll
        for (int ks = 0; ks < 6; ++ks) { raw[ks] = *(const u32x4*)(qp + 16 * ks);
            const float a0 = bf_lo(raw[ks].x), a1 = bf_hi(raw[ks].x), a2 = bf_lo(raw[ks].y), a3 = bf_hi(raw[ks].y), a4 = bf_lo(raw[ks].z), a5 = bf_hi(raw[ks].z), a6 = bf_lo(raw[ks].w), a7 = bf_hi(raw[ks].w);
            ss += (a0 * a0 + a1 * a1) + (a2 * a2 + a3 * a3) + (a4 * a4 + a5 * a5) + (a6 * a6 + a7 * a7); }
        ss += __shfl_xor(ss, 32);
        const float rstd = rsqrtf(ss * (1.0f / DQK) + EPS) * QSCALE;
        const int tl = (qrow0 - krow0 - CTX) + wid * 32 + l32;
        const float sgn = hi ? 1.0f : -1.0f;
#pragma unroll
        for (int ks = 0; ks < 6; ++ks) {
            const f32x4 g0 = *(const f32x4*)(qgain + 16 * ks + 8 * hi), g1 = *(const f32x4*)(qgain + 16 * ks + 8 * hi + 4);
            float y[8] = {bf_lo(raw[ks].x) * rstd * g0[0], bf_hi(raw[ks].x) * rstd * g0[1], bf_lo(raw[ks].y) * rstd * g0[2], bf_hi(raw[ks].y) * rstd * g0[3],
                          bf_lo(raw[ks].z) * rstd * g1[0], bf_hi(raw[ks].z) * rstd * g1[1], bf_lo(raw[ks].w) * rstd * g1[2], bf_hi(raw[ks].w) * rstd * g1[3]};
            if (ks >= 4) {
                const float pos = rope_on ? (float)((ks == 4) ? (tl >> 6) : (tl & 63)) : 0.f;
#pragma unroll
                for (int i = 0; i < 8; ++i) { const float ang = pos * __builtin_amdgcn_exp2f(-(float)i * (13.287712379549449f / 8.0f)); const float py = __shfl_xor(y[i], 32);
                    y[i] = y[i] * __cosf(ang) + py * (__sinf(ang) * sgn); }
            }
            u32x4 w; w.x = cvt_pk_bf16(y[0], y[1]); w.y = cvt_pk_bf16(y[2], y[3]); w.z = cvt_pk_bf16(y[4], y[5]); w.w = cvt_pk_bf16(y[6], y[7]);
            qf[ks] = __builtin_bit_cast(bf16x8, w);
        }
    }
    f32x16 o0, o1;
#pragma unroll
    for (int i = 0; i < 16; ++i) { o0[i] = 0.f; o1[i] = 0.f; }
    float lsum = 0.f;
    const int ntiles = nk / 64;
    const int kr0 = tid / 12, kc0 = tid % 12, kr1 = (tid + 512) / 12, kc1 = (tid + 512) % 12;
    const int vr = tid >> 3, vc = tid & 7;
    const bf16_t* kg0 = Kb + (size_t)(krow0 + kr0) * 768 + h * 96 + kc0 * 8;
    const bf16_t* kg1 = Kb + (size_t)(krow0 + kr1) * 768 + h * 96 + kc1 * 8;
    const bf16_t* vg = VT + (size_t)(h * 64 + vr) * T + krow0 + vc * 8;
    const int kl0 = kr0 * KPITCH + kc0 * 16, kl1 = kr1 * KPITCH + kc1 * 16;
    const int vl = 3 * KBUF + vr * VPITCH + (vc >> 1) * 32 + (vc & 1) * 8;
    const bool two = tid < 256;
    u32x4 rk0, rk1 = (u32x4){0, 0, 0, 0}, rv;
#define ATT_LDK(tt) do { rk0 = *(const u32x4*)(kg0 + (size_t)(tt) * 64 * 768); if (two) rk1 = *(const u32x4*)(kg1 + (size_t)(tt) * 64 * 768); } while (0)
#define ATT_STK(slot) do { *(LAS u32x4*)(lds + (slot) * KBUF + kl0) = rk0; if (two) *(LAS u32x4*)(lds + (slot) * KBUF + kl1) = rk1; } while (0)
#define ATT_LDV(tt) do { rv = *(const u32x4*)(vg + (tt) * 64); } while (0)
#define ATT_STV(slot) do { *(LAS u32x2*)(lds + (slot) * VBUF + vl) = (u32x2){rv.x, rv.y}; *(LAS u32x2*)(lds + (slot) * VBUF + vl + 16) = (u32x2){rv.z, rv.w}; } while (0)
#define ATT_QK(S0, S1, slot) do { const LAS unsigned char* kb = lds + (slot) * KBUF; _Pragma("unroll") for (int i = 0; i < 16; ++i) { S0[i] = -SSHIFT; S1[i] = -SSHIFT; } \
        _Pragma("unroll") for (int ks = 0; ks < 6; ++ks) { \
            const bf16x8 a0 = *(const LAS bf16x8*)(kb + l32 * KPITCH + ks * 32 + hi * 16); const bf16x8 a1 = *(const LAS bf16x8*)(kb + (32 + l32) * KPITCH + ks * 32 + hi * 16); \
            S0 = __builtin_amdgcn_mfma_f32_32x32x16_bf16(a0, qf[ks], S0, 0, 0, 0); S1 = __builtin_amdgcn_mfma_f32_32x32x16_bf16(a1, qf[ks], S1, 0, 0, 0); } } while (0)
#define ATT_EXP1(C0, C1, fi) do { if ((fi) < 16) { C0[(fi) & 15] = __builtin_amdgcn_exp2f(C0[(fi) & 15]); ps += C0[(fi) & 15]; } else if ((fi) < 32) { C1[(fi) & 15] = __builtin_amdgcn_exp2f(C1[(fi) & 15]); ps += C1[(fi) & 15]; } } while (0)
#define ATT_STEP(C0, C1, N0, N1, tt, ks_next, ks_store, vs_cur, vs_store) do { \
        const bool h1 = (tt) + 1 < ntiles, h2 = (tt) + 2 < ntiles; \
        if (h2) ATT_LDK((tt) + 2); \
        if (h1) ATT_LDV((tt) + 1); \
        float ps = 0.f; \
        { const LAS unsigned char* kb = lds + (ks_next) * KBUF; _Pragma("unroll") for (int i = 0; i < 16; ++i) { N0[i] = -SSHIFT; N1[i] = -SSHIFT; } \
          __builtin_amdgcn_sched_barrier(0); __builtin_amdgcn_s_setprio(1);     \
          _Pragma("unroll") for (int ks = 0; ks < 6; ++ks) {     \
            const bf16x8 a0 = *(const LAS bf16x8*)(kb + l32 * KPITCH + ks * 32 + hi * 16); const bf16x8 a1 = *(const LAS bf16x8*)(kb + (32 + l32) * KPITCH + ks * 32 + hi * 16); \
            N0 = __builtin_amdgcn_mfma_f32_32x32x16_bf16(a0, qf[ks], N0, 0, 0, 0); N1 = __builtin_amdgcn_mfma_f32_32x32x16_bf16(a1, qf[ks], N1, 0, 0, 0); \
            _Pragma("unroll") for (int e_ = 0; e_ < 6; ++e_) ATT_EXP1(C0, C1, ks * 6 + e_); \
            __builtin_amdgcn_sched_barrier(0); } } \
        lsum += ps; \
        bf16x8 pf[4]; \
        _Pragma("unroll") for (int jj = 0; jj < 2; ++jj) { u32x4 w0, w1; \
            w0.x = cvt_pk_bf16(C0[8 * jj + 0], C0[8 * jj + 1]); w0.y = cvt_pk_bf16(C0[8 * jj + 2], C0[8 * jj + 3]); w0.z = cvt_pk_bf16(C0[8 * jj + 4], C0[8 * jj + 5]); w0.w = cvt_pk_bf16(C0[8 * jj + 6], C0[8 * jj + 7]); \
            w1.x = cvt_pk_bf16(C1[8 * jj + 0], C1[8 * jj + 1]); w1.y = cvt_pk_bf16(C1[8 * jj + 2], C1[8 * jj + 3]); w1.z = cvt_pk_bf16(C1[8 * jj + 4], C1[8 * jj + 5]); w1.w = cvt_pk_bf16(C1[8 * jj + 6], C1[8 * jj + 7]); \
            pf[jj] = __builtin_bit_cast(bf16x8, w0); pf[2 + jj] = __builtin_bit_cast(bf16x8, w1); } \
        { const LAS unsigned char* vb = lds + 3 * KBUF + (vs_cur) * VBUF; \
          _Pragma("unroll") for (int jj = 0; jj < 4; ++jj) { \
            const bf16x8 v0 = *(const LAS bf16x8*)(vb + l32 * VPITCH + jj * 32 + hi * 16); const bf16x8 v1 = *(const LAS bf16x8*)(vb + (32 + l32) * VPITCH + jj * 32 + hi * 16); \
            o0 = __builtin_amdgcn_mfma_f32_32x32x16_bf16(v0, pf[jj], o0, 0, 0, 0); o1 = __builtin_amdgcn_mfma_f32_32x32x16_bf16(v1, pf[jj], o1, 0, 0, 0); } } \
        __builtin_amdgcn_s_setprio(0); \
        if (h2) ATT_STK(ks_store); \
        if (h1) ATT_STV(vs_store); \
        __syncthreads(); } while (0)
    ATT_LDK(0); ATT_LDV(0);
    const u32x4 kx0 = *(const u32x4*)(kg0 + (size_t)64 * 768); u32x4 kx1 = (u32x4){0, 0, 0, 0}; if (two) kx1 = *(const u32x4*)(kg1 + (size_t)64 * 768);
    ATT_STK(0); ATT_STV(0);
    rk0 = kx0; rk1 = kx1; ATT_STK(1);
    __syncthreads();
    f32x16 sa0, sa1, sb0, sb1;
    ATT_QK(sa0, sa1, 0);
    int k0s = 0;
    for (int t = 0; t < ntiles; t += 2) {
        const int k1s = (k0s == 2) ? 0 : k0s + 1, k2s = (k1s == 2) ? 0 : k1s + 1;
        ATT_STEP(sa0, sa1, sb0, sb1, t, k1s, k2s, 0, 1);
        ATT_STEP(sb0, sb1, sa0, sa1, t + 1, k2s, k0s, 1, 0);
        k0s = k2s;
    }
#undef ATT_LDK
#undef ATT_STK
#undef ATT_LDV
#undef ATT_STV
#undef ATT_QK
#undef ATT_STEP
#undef ATT_EXP1
    const float ltot = lsum + __shfl_xor(lsum, 32), inv = __builtin_amdgcn_rcpf(ltot);
    bf16_t* op = cat + (size_t)(qrow0 + wid * 32 + l32) * DM + h * 64 + 4 * hi;
#pragma unroll
    for (int q = 0; q < 4; ++q) {
        u32x2 w; w.x = cvt_pk_bf16(o0[4 * q] * inv, o0[4 * q + 1] * inv); w.y = cvt_pk_bf16(o0[4 * q + 2] * inv, o0[4 * q + 3] * inv);
        *(u32x2*)(op + 8 * q) = w;
        w.x = cvt_pk_bf16(o1[4 * q] * inv, o1[4 * q + 1] * inv); w.y = cvt_pk_bf16(o1[4 * q + 2] * inv, o1[4 * q + 3] * inv);
        *(u32x2*)(op + 32 + 8 * q) = w;
    }
}
__device__ __forceinline__ void attn_phase(const Args& a, int l, LAS unsigned char* lds, const int tid, const int bid) {
    const bf16_t* Q = (const bf16_t*)(a.ws + WS_Q); const bf16_t* Kb = (const bf16_t*)(a.ws + WS_K); const bf16_t* VT = (const bf16_t*)(a.ws + WS_VT);
    bf16_t* cat = (bf16_t*)a.out;
    const int nunits = (l == DEPTH - 1) ? 1024 : 1152;
    for (int i = bid; i < nunits; i += gridDim.x) {
        int pair, qb;
        if (i < 1024) { const int r = i >> 8, c = i & 255; pair = r * 32 + (c & 7) * 4 + (c >> 6); qb = ((c >> 3) & 7) + 1; }
        else { pair = i - 1024; qb = 0; }
        const int b = pair >> 3, h = pair & 7;
        attn_unit(lds, Q, Kb, VT, cat, a.in[13] + (size_t)l * DQK, qb != 0, h, b * TPB + qb * 256, b * TPB, qb == 0 ? CTX : TPB, tid);
    }
}

__device__ __forceinline__ void scan_s1(const Args& a, const int tid, const int bid) {
    const unsigned* ab = (const unsigned*)(a.ws + WS_AB); float* sums = (float*)(a.ws + WS_SUMS);
    const int ch = tid;
    for (int it = bid; it < NB * NCHUNK * 2; it += gridDim.x) {
        const int d = it & 1, bc = it >> 1, b = bc / NCHUNK, c = bc % NCHUNK, t0 = b * TPB + c * 64;
        float hs = 0.f, sl = 0.f;
#pragma unroll 8
        for (int i = 0; i < 64; ++i) {
            const int t = d == 0 ? t0 + i : t0 + 63 - i;
            const h16x2 v = __builtin_bit_cast(h16x2, ab[((size_t)t * 2 + d) * 512 + ch]);
            const float la = (float)v.x, bb = (float)v.y;
            hs = __expf(la) * hs + bb; sl += la;
        }
        *(float2*)(sums + (((size_t)bc * 2 + d) * 512 + ch) * 2) = make_float2(sl, hs);
    }
}
__device__ __forceinline__ void scan_s3(const Args& a, const int tid, const int bid, const int last) {
    const unsigned* ab = (const unsigned*)(a.ws + WS_AB); const float* sums = (const float*)(a.ws + WS_SUMS);
    const bf16_t* g = (const bf16_t*)(a.ws + WS_G); bf16_t* cat = (bf16_t*)a.out;
    const int ch = tid;
    const bool deal = (gridDim.x == 256);
    for (int k = 0; k < 3; ++k) {
        int bc = bid + (int)gridDim.x * k;
        if (deal && k == 2) bc = (bid >= 128 && bid < 192) ? bid - 128 + 512 : NB * NCHUNK;
        if (bc >= NB * NCHUNK) break;
        const int b = bc / NCHUNK, c = bc % NCHUNK, t0 = b * TPB + c * 64;
        if (last && c < 4) continue;
        const float* sb = sums + (size_t)b * NCHUNK * 2 * 512 * 2;
        float hf = 0.f, hb = 0.f;
        {
            float2 v[NCHUNK];
#pragma unroll
            for (int k = 0; k < NCHUNK; ++k) v[k] = *(const float2*)(sb + (((size_t)k * 2 + 0) * 512 + ch) * 2);
#pragma unroll
            for (int k = 0; k < NCHUNK; ++k) { const bool use = k < c; const float aa = use ? __expf(v[k].x) : 1.0f, bb = use ? v[k].y : 0.f; hf = aa * hf + bb; }
            const int pos = (c < 4) ? 3 - c : 4 + (NCHUNK - 1 - c);
#pragma unroll
            for (int k = 0; k < NCHUNK; ++k) { const int cc = (k < 4) ? 3 - k : NCHUNK + 3 - k; v[k] = *(const float2*)(sb + (((size_t)cc * 2 + 1) * 512 + ch) * 2); }
#pragma unroll
            for (int k = 0; k < NCHUNK; ++k) { const bool use = k < pos; const float aa = use ? __expf(v[k].x) : 1.0f, bb = use ? v[k].y : 0.f; hb = aa * hb + bb; }
        }
        float hfs[64];
#pragma unroll
        for (int i = 0; i < 64; ++i) {
            const h16x2 v = __builtin_bit_cast(h16x2, __builtin_nontemporal_load(ab + ((size_t)(t0 + i) * 2 + 0) * 512 + ch));
            hf = __expf((float)v.x) * hf + (float)v.y; hfs[i] = hf;
        }
#pragma unroll
        for (int i0 = 48; i0 >= 0; i0 -= 16) {
            unsigned av[16]; bf16_t gv[16];
#pragma unroll
            for (int j = 0; j < 16; ++j) { av[j] = __builtin_nontemporal_load(ab + ((size_t)(t0 + i0 + j) * 2 + 1) * 512 + ch); gv[j] = __builtin_nontemporal_load(g + (size_t)(t0 + i0 + j) * 512 + ch); }
#pragma unroll
            for (int j = 15; j >= 0; --j) {
                const h16x2 v = __builtin_bit_cast(h16x2, av[j]);
                hb = __expf((float)v.x) * hb + (float)v.y;
                cat[(size_t)(t0 + i0 + j) * DM + 512 + ch] = f2bf((hfs[i0 + j] + hb) * gelu_tanh(bf1(gv[j])));
            }
        }
    }
}

#define XB_TMO      128
#define XB_XCNT(j)  (256  + 64 * (j))
#define XB_XSUB(j)  (1280 + 64 * (j))
#define XB_XGEN(j)  (2304 + 64 * (j))
#define XB_TOP      3328
#define XB_TOPGEN   3392
#define XCD_BAR_WORDS 3456
#define XB_SPIN_CAP (1u << 18)

__device__ __forceinline__ unsigned xb_ld(unsigned* p)              { return __hip_atomic_load(p, __ATOMIC_RELAXED, __HIP_MEMORY_SCOPE_AGENT); }
__device__ __forceinline__ unsigned xb_add(unsigned* p, unsigned v) { return __hip_atomic_fetch_add(p, v, __ATOMIC_RELAXED, __HIP_MEMORY_SCOPE_AGENT); }
__device__ __forceinline__ unsigned xb_xcc_id() { return (unsigned)__builtin_amdgcn_s_getreg((3 << 11) | 20) & 0xFu; }
#define XB_SPIN(cond, bar) do { unsigned _sp = 0; while (cond) { __builtin_amdgcn_s_sleep(1); \
    if ((++_sp & 255u) == 0u) { if (xb_ld(&(bar)[XB_TMO])) break; if (_sp > XB_SPIN_CAP) { atomicAdd(&(bar)[XB_TMO], 1u); break; } } } } while (0)

struct XcdBarrier {
    unsigned* bar; unsigned x;
    volatile LAS unsigned* st;
};

__device__ __forceinline__ XcdBarrier xcd_barrier_post(unsigned* bar, volatile LAS unsigned* st) {
    XcdBarrier b; b.bar = bar; b.x = xb_xcc_id(); b.st = st;
    if (threadIdx.x == 0) (void)xb_add(&bar[XB_XCNT(b.x)], 1u);
    return b;
}
__device__ __forceinline__ void xcd_barrier_complete(unsigned* bar, unsigned x, unsigned& nloc, unsigned& nx) {
    const unsigned G = gridDim.x * gridDim.y * gridDim.z;
    unsigned sum, cnt, mine, sp = 0u;
    for (;;) {
        sum = 0u; cnt = 0u; mine = 0u;
#pragma unroll
        for (unsigned j = 0; j < 16; ++j) { const unsigned c = xb_ld(&bar[XB_XCNT(j)]); sum += c; cnt += (c > 0u) ? 1u : 0u; mine = (j == x) ? c : mine; }
        if (sum == G) break;
        __builtin_amdgcn_s_sleep(1);
        if ((++sp & 255u) == 0u) { if (xb_ld(&bar[XB_TMO])) break; if (sp > XB_SPIN_CAP) { atomicAdd(&bar[XB_TMO], 1u); break; } }
    }
    nloc = mine > 0u ? mine : 1u; nx = cnt > 0u ? cnt : 1u;
}

__device__ __forceinline__ void xcd_barrier(const XcdBarrier& b) {
    asm volatile("s_waitcnt vmcnt(0)" ::: "memory");
    __syncthreads();
    if (threadIdx.x == 0) {
        unsigned* bar = b.bar;
        __builtin_amdgcn_s_waitcnt(0);
        unsigned nloc = b.st[0], nx = b.st[1];
        if (nloc == 0u) { xcd_barrier_complete(bar, b.x, nloc, nx); b.st[0] = nloc; b.st[1] = nx; }
        const unsigned old = xb_add(&bar[XB_XSUB(b.x)], 1u);
        const unsigned gen = old / nloc;
        if (old + 1u == (gen + 1u) * nloc) {
            __builtin_amdgcn_fence(__ATOMIC_RELEASE, "agent");
            asm volatile("s_waitcnt vmcnt(0)" ::: "memory");
            const unsigned og = xb_add(&bar[XB_TOP], 1u);
            const unsigned tg = og / nx;
            if (og + 1u == (tg + 1u) * nx) xb_add(&bar[XB_TOPGEN], 1u);
            else XB_SPIN(xb_ld(&bar[XB_TOPGEN]) == tg, bar);
            __builtin_amdgcn_fence(__ATOMIC_ACQUIRE, "agent");
            xb_add(&bar[XB_XGEN(b.x)], 1u);
            asm volatile("s_waitcnt vmcnt(0)" ::: "memory");
        } else {
            XB_SPIN(xb_ld(&bar[XB_XGEN(b.x)]) == gen, bar);
            __builtin_amdgcn_fence(__ATOMIC_ACQUIRE, "agent");
            asm volatile("s_waitcnt vmcnt(0)" ::: "memory");
        }
    }
    __syncthreads();
}


__device__ __forceinline__ int fresh_lane() { int l; asm volatile("v_mbcnt_lo_u32_b32 %0, -1, 0\n\tv_mbcnt_hi_u32_b32 %0, -1, %0" : "=v"(l)); return l; }
#ifndef PHASE_MASK
#define PHASE_MASK 0xFFF
#endif
#ifndef P3SEL
#define P3SEL 7
#endif
#define PH_ON(k) (((PHASE_MASK) >> (k)) & 1)
#ifndef PROBE_REP_MASK
#define PROBE_REP_MASK 0
#endif
#ifndef PROBE_CASE
#define PROBE_CASE -1
#endif
#ifndef PROBE_N
#define PROBE_N 2
#endif
#define REPS(k) for (int rep_ = 0; rep_ < ((PROBE_CASE == (k)) ? PROBE_N : 1); ++rep_)
constexpr int PPL = 10, PPLX = PPL + __builtin_popcount(PROBE_REP_MASK), NPHASE = 1 + DEPTH * PPLX;
typedef const __attribute__((address_space(4))) Args* ArgsP;
#define LD_IN(k) la.in[k] = ap->in[k]
__global__ void __launch_bounds__(512) fwd_kernel(Args a_unused) {
    extern __shared__ __attribute__((aligned(16))) unsigned char lds_raw[];
    LAS unsigned char* lds = (LAS unsigned char*)lds_raw;
    const int G = gridDim.x, NGW = G * 8;
    const int wid0 = __builtin_amdgcn_readfirstlane((int)threadIdx.x >> 6);
    ArgsP ap0 = (ArgsP)__builtin_amdgcn_kernarg_segment_ptr();
    const int ph_lo = ap0->ph_lo, ph_hi = ap0->ph_hi;
    volatile LAS unsigned* bst = (volatile LAS unsigned*)(lds + LDS_BARST);
    if (threadIdx.x < 2) bst[threadIdx.x] = 0u;
    __syncthreads();
    const XcdBarrier xbar = xcd_barrier_post((unsigned*)(ap0->ws + WS_BAR), bst);
    for (int ph = ph_lo; ph < ph_hi; ++ph) {
        if (ph > ph_lo) { if (ph == ph_lo + 1) cg::this_grid().sync(); else xcd_barrier(xbar); }
        ArgsP ap = ap0; asm volatile("" : "+s"(ap));
        int wid_ = wid0, bid_ = blockIdx.x; asm volatile("" : "+s"(wid_)); asm volatile("" : "+s"(bid_));
        const int wid = wid_, bid = bid_, gw = bid * 8 + wid;
#define TID (wid * 64 + fresh_lane())
#define LANE (fresh_lane())
        Args la; la.ws = ap->ws; la.out = ap->out;
        unsigned char* ws = la.ws;
        if (ph == 0) { if (PH_ON(11)) { LD_IN(1); LD_IN(3); LD_IN(4); LD_IN(5); mod_phase(la, lds, TID, 0, 96, bid, G); } continue; }
        const int l = (ph - 1) / PPLX; int lp = (ph - 1) % PPLX; if (!PROBE_REP_MASK && lp >= 6) lp += 1;
        int probe_first = 0;
        if (PROBE_REP_MASK) { const int e = lp; int cnt = 0; for (int q = 0; q < PPL; ++q) { const int n = 1 + ((PROBE_REP_MASK >> q) & 1); if (e < cnt + n) { lp = q; probe_first = (n == 2 && e == cnt) ? 1 : 0; break; } cnt += n; } }
        const float* modl = (const float*)(ws + WS_MOD) + (size_t)l * 17 * NMOD;
        bf16_t* wt = (bf16_t*)(ws + WS_WT);
        bf16_t* H = (bf16_t*)la.out;
        bf16_t* xr = (bf16_t*)(ws + WS_XR);
        pg8::StaticOrder S;
        const int last = (l == DEPTH - 1) ? 1 : 0;
        switch (lp) {
        case 0: if (PH_ON(0)) REPS(0) {
            LD_IN(8); LD_IN(9); LD_IN(10); LD_IN(11); LD_IN(12); LD_IN(17); LD_IN(19); LD_IN(22); LD_IN(23); LD_IN(24);
            if (l == 0) convert_weights(la, l, lds, gw, NGW, wid, LANE);
            if (bid == G - 1) { const float* lam = ap->in[21] + (size_t)l * 1024; float* sp8 = (float*)(ws + WS_SP);
                for (int i = TID; i < 1024; i += 512) { const float z = -lam[i]; const float e = __expf(-fabsf(z)); const float lp = e < 0.03f ? e * (1.0f - e * (0.5f - e * (0.33333334f - 0.25f * e))) : __logf(1.0f + e); sp8[i] = 8.0f * (fmaxf(z, 0.f) + lp); } }
            const float* gain = ap->in[6] + (size_t)l * DM;
            { const int per = (T + NGW - 1) / NGW, tb = gw * per, te = (tb + per < T) ? tb + per : T;
              if (l == 0) norm_rows_in(tb, te, ap->in[0], ap->in[2], xr, modl, 0, DM, gain, H, LANE); else norm_rows(tb, te, xr, modl, 0, DM, gain, H, LANE, nullptr); }
        } break;
        case 1: if (PH_ON(1)) REPS(1) {
            pg8::Gemm g{H, wt + WT_IN / 2, T, IN_PAD, DM, DM, DM}; S.init(T, IN_PAD, G, bid);
            pg8::EpiStore<1> E{nullptr, 0, (bf16_t*)(ws + WS_CQ), (bf16_t*)(ws + WS_CKV), (bf16_t*)(ws + WS_KR), (bf16_t*)(ws + WS_U), (bf16_t*)(ws + WS_G), (float*)(ws + WS_RSS), nullptr, 0.f, 0};
            pg8::gemm_phase<pg8::EpiStore<1>, true>(lds, g, S, E, TID);
        } break;
        case 2: if (PH_ON(2)) REPS(2) { LD_IN(15); LD_IN(16); const int per = (T + NGW - 1) / NGW, tb = gw * per, te = (tb + per < T) ? tb + per : T; mid_rows(la, l, tb, te, LANE); } break;
        case 3: if (PH_ON(3)) REPS(3) {
            if (P3SEL & 1) { pg8::Gemm g{(const bf16_t*)(ws + WS_CQ), wt + WT_UQ / 2, T, 768, QR, QR, QR}; S.init(last ? TLAT : T, 768, G, bid, last);
              pg8::EpiStore<0> E{(bf16_t*)(ws + WS_Q), 768, nullptr, nullptr, nullptr, nullptr, nullptr, nullptr, (const float*)(ws + WS_RSTD), 1.0f / QR, 0};
              pg8::gemm_phase<pg8::EpiStore<0>, true>(lds, g, S, E, TID); }
            if (P3SEL & 2) { pg8::Gemm g{(const bf16_t*)(ws + WS_CKV), wt + WT_KN / 2, T, 512, KVR, KVR, KVR}; S.init(T, 512, G, (bid + 80) % G);
              pg8::EpiStore<2> E{(bf16_t*)(ws + WS_K), 768, nullptr, nullptr, nullptr, nullptr, nullptr, nullptr, (const float*)(ws + WS_RSTD) + T, 1.0f / KVR, 0};
              pg8::gemm_phase<pg8::EpiStore<2>, true>(lds, g, S, E, TID); }
            if (P3SEL & 4) { pg8::Gemm g{wt + WT_VT / 2, (const bf16_t*)(ws + WS_CKV), 512, T, KVR, KVR, KVR}; S.init(512, T, G, (bid + 48) % G);
              pg8::EpiStore<0> E{(bf16_t*)(ws + WS_VT), T, nullptr, nullptr, nullptr, nullptr, nullptr, nullptr, (const float*)(ws + WS_RSTD) + T, 1.0f / KVR, 1};
              pg8::gemm_phase<pg8::EpiStore<0>, true>(lds, g, S, E, TID); }
        } break;
        case 4: if (PH_ON(4)) {
            LD_IN(14);
            const float* ba = ap->in[18] + (size_t)l * 1024; const float* bx = ap->in[20] + (size_t)l * 1024;
            for (int half_ = 0; half_ < 2; ++half_) if ((half_ ^ (bid & 1)) == 0) {
            { pg8::EpiGates E{ba, bx, (const float*)(ws + WS_SP), (const bf16_t*)(ws + WS_UC), (unsigned*)(ws + WS_AB)};
              REPS(4) gates_phase(lds, (const bf16_t*)(ws + WS_UC), wt + WT_G0 / 2, E, (float*)(ws + WS_SUMS), TID, bid, G); }
            } else {
            if (!probe_first) { const int per = (T + NGW - 1) / NGW, tb = gw * per, te = (tb + per < T) ? tb + per : T; fin_rows(la, l, tb, te, LANE); }
            }
        } break;
        case 5: if (PH_ON(5)) REPS(5) { LD_IN(13);
            for (int half_ = 0; half_ < 2; ++half_) { if ((half_ ^ (bid & 1)) == 0) attn_phase(la, l, lds, TID, bid); else { REPS(6) scan_s3(la, TID, bid, last); } } } break;
        case 7: if (PH_ON(7)) {
            pg8::Gemm g{H, wt + WT_OUT / 2, T, DM, DM, DM, DM}; S.init(last ? TLAT : T, DM, G, bid, last);
            pg8::EpiResid<false> E{modl + 2 * DM, xr, nullptr};
            pg8::gemm_phase<pg8::EpiResid<false>, true>(lds, g, S, E, TID);
            if (!last) {
                const int nx = ((T / 256) * (DM / 256)) % G, idle = G - nx;
                if (bid >= nx && bid - nx < 96) { LD_IN(1); LD_IN(3); LD_IN(4); LD_IN(5); mod_phase(la, lds, TID, 96 * (l + 1), 96 * (l + 2), bid - nx, idle); }
            }
        } break;
        case 8: if (PH_ON(8)) REPS(8) { const float* gain = ap->in[7] + (size_t)l * DM; const int per = (T + NGW - 1) / NGW, tb = gw * per, te = (tb + per < T) ? tb + per : T; norm_rows(tb, te, xr, modl, 3 * DM, 4 * DM, gain, H, LANE, nullptr); } break;
        case 9: if (PH_ON(9)) REPS(9) {
            pg8::Gemm g{H, wt + WT_FFI / 2, T, 2 * DFF, DM, DM, DM}; S.init(last ? TLAT : T, 2 * DFF, G, bid, last);
            pg8::EpiSwiglu E{(bf16_t*)(ws + WS_FF)};
            pg8::gemm_phase<pg8::EpiSwiglu, true>(lds, g, S, E, TID);
        } break;
        default: if (PH_ON(10)) {
            pg8::Gemm g{(const bf16_t*)(ws + WS_FF), wt + ((l & 1) ? (WS_FFO_ALT - WS_WT) : WT_FFO) / 2, T, DM, DFF, DFF, DFF}; S.init(last ? TLAT : T, DM, G, bid, last);
            if (last) { pg8::EpiResid<true> E{modl + 5 * DM, xr, la.out}; pg8::gemm_phase<pg8::EpiResid<true>, true>(lds, g, S, E, TID); }
            else { pg8::EpiResid<false> E{modl + 5 * DM, xr, nullptr}; pg8::gemm_phase<pg8::EpiResid<false>, true>(lds, g, S, E, TID); }
            if (!last) {
                const int nx = ((T / 256) * (DM / 256)) % G;
                if (bid >= nx) { LD_IN(8); LD_IN(9); LD_IN(10); LD_IN(11); LD_IN(12); LD_IN(17); LD_IN(19); LD_IN(22); LD_IN(23); LD_IN(24);
                    convert_weights(la, l + 1, lds, (bid - nx) * 8 + wid, (G - nx) * 8, wid, LANE); }
            }
        } break;
        }
    }
}

#undef TID
#undef LANE
extern "C" void kernel_launch(void* const* d_in, const int* in_sizes, int n_in, void* d_out, int out_size, void* d_ws, size_t ws_size, hipStream_t stream) {
    static int grid = 0;
    if (grid == 0) {
        if (n_in != 25 || out_size != NB * SEQ * DM || ws_size < WS_END) { fprintf(stderr, "kernel_launch: unexpected shapes (n_in %d out %d ws %zu)\n", n_in, out_size, ws_size); grid = -1; return; }
        int dev = 0, cus = 0, per_cu = 0;
        hipGetDevice(&dev); hipDeviceGetAttribute(&cus, hipDeviceAttributeMultiprocessorCount, dev);
        hipFuncSetAttribute((const void*)fwd_kernel, hipFuncAttributeMaxDynamicSharedMemorySize, LDS_BYTES);
        hipOccupancyMaxActiveBlocksPerMultiprocessor(&per_cu, (const void*)fwd_kernel, 512, LDS_BYTES);
        if (per_cu < 1) { fprintf(stderr, "kernel_launch: occupancy query says %d blocks per CU\n", per_cu); per_cu = 1; }
        grid = cus * per_cu;
        (void)hipGetLastError();
    }
    if (grid < 0) return;
    Args a{};
    for (int i = 0; i < 25; ++i) a.in[i] = (const float*)d_in[i];
    a.out = (float*)d_out; a.ws = (unsigned char*)d_ws;
    if (hipMemsetAsync((unsigned char*)d_ws + WS_BAR, 0, BAR_BYTES, stream) != hipSuccess) { fprintf(stderr, "kernel_launch: hipMemsetAsync of the barrier words failed\n"); return; }
#if MK_MULTI_LAUNCH
    for (int ph = 0; ph < NPHASE; ++ph) { a.ph_lo = ph; a.ph_hi = ph + 1; hipLaunchKernelGGL(fwd_kernel, dim3(grid), dim3(512), LDS_BYTES, stream, a); }
#else
    a.ph_lo = 0; a.ph_hi = NPHASE;
    void* args[] = {&a};
    hipError_t e = hipLaunchCooperativeKernel((const void*)fwd_kernel, dim3(grid), dim3(512), args, LDS_BYTES, stream);
    if (e != hipSuccess) fprintf(stderr, "cooperative launch failed: %s (grid %d)\n", hipGetErrorString(e), grid);
#endif
}
```

```cpp
#include <hip/hip_runtime.h>
#include <hip/hip_cooperative_groups.h>
#include <cstdio>
#include <cstdint>
#include <utility>
namespace cg = cooperative_groups;

#ifndef MK_MULTI_LAUNCH
#define MK_MULTI_LAUNCH 0
#endif

#define LAS __attribute__((address_space(3)))
typedef unsigned short bf16_t;
typedef short bf16x8 __attribute__((ext_vector_type(8)));
typedef float f32x4 __attribute__((ext_vector_type(4)));
typedef float f32x16 __attribute__((ext_vector_type(16)));
typedef unsigned u32x4 __attribute__((ext_vector_type(4)));
typedef unsigned u32x2 __attribute__((ext_vector_type(2)));
typedef _Float16 h16x2 __attribute__((ext_vector_type(2)));

constexpr int DM = 1024, NB = 16, SEQ = 2048, CTX = 256, TPB = SEQ + CTX, T = NB * TPB, DEPTH = 4;
constexpr int NH = 8, DQK = 96, QR = 384, KVR = 256, LRU = 512, DFF = 2816, IN_DIM = 1696, IN_PAD = 1792, NMOD = 6 * DM;
constexpr int TLAT = NB * SEQ;
constexpr int NCHUNK = TPB / 64;
constexpr float EPS = 1e-6f;
constexpr float QSCALE = 0.10206207261596577f * 1.4426950408889634f;

constexpr size_t MiB = 1u << 20;
constexpr size_t WS_MOD = 0, WS_SP = 1835008, WS_BAR = 1900544, BAR_BYTES = 16384;
constexpr size_t WS_WT = 2 * MiB;
constexpr size_t WT_IN = 0, WT_UQ = WT_IN + (size_t)IN_PAD * 1024 * 2, WT_KN = WT_UQ + (size_t)768 * 384 * 2, WT_VT = WT_KN + (size_t)512 * 256 * 2,
                 WT_G0 = WT_VT + (size_t)512 * 256 * 2, WT_G1 = WT_G0 + (size_t)1024 * 256 * 2, WT_OUT = WT_G1 + (size_t)1024 * 256 * 2,
                 WT_FFI = WT_OUT + (size_t)1024 * 1024 * 2, WT_FFO = WT_FFI + (size_t)5632 * 1024 * 2, WT_END = WT_FFO + (size_t)1024 * 2816 * 2;
static_assert(WT_END <= 26 * MiB, "weights region");
constexpr size_t WS_FFO_ALT = 28 * MiB;
constexpr size_t WS_RSS = 36 * MiB, WS_RSTD = 40 * MiB;
constexpr size_t WS_XR = 44 * MiB,
                  WS_SUMS = 116 * MiB, WS_G = 121 * MiB, WS_KR = 157 * MiB, WS_UC = 160 * MiB,
                 WS_Q = 196 * MiB, WS_K = 250 * MiB, WS_VT = 304 * MiB, WS_AB = 340 * MiB, WS_U = 340 * MiB, WS_CQ = 376 * MiB, WS_CKV = 403 * MiB,
                 WS_FF = 121 * MiB, WS_END = 484 * MiB;
static_assert(WS_FF + (size_t)T * DFF * 2 <= WS_AB + (size_t)T * 2 * 512 * 4, "ff overlay");
static_assert(WS_AB + (size_t)T * 2 * 512 * 4 <= WS_END, "ab");

constexpr int LDS_BYTES = 131072 + 8192, LDS_BARST = 131072 + 4096;

struct Args { const float* in[25]; float* out; unsigned char* ws; int ph_lo, ph_hi; };

__device__ __forceinline__ unsigned cvt_pk_bf16(float lo, float hi) { unsigned r; asm volatile("v_cvt_pk_bf16_f32 %0, %1, %2" : "=v"(r) : "v"(lo), "v"(hi)); return r; }
__device__ __forceinline__ float bf_lo(unsigned u) { return __uint_as_float(u << 16); }
__device__ __forceinline__ float bf_hi(unsigned u) { return __uint_as_float(u & 0xffff0000u); }
__device__ __forceinline__ float bf1(bf16_t u) { return __uint_as_float((unsigned)u << 16); }
__device__ __forceinline__ bf16_t f2bf(float f) { return (bf16_t)(cvt_pk_bf16(f, 0.f) & 0xffffu); }
__device__ __forceinline__ float wave_sum(float v) {
#pragma unroll
    for (int o = 1; o < 64; o <<= 1) v += __shfl_xor(v, o);
    return v;
}
__device__ __forceinline__ float sigmoidf_(float x) { return __builtin_amdgcn_rcpf(1.0f + __expf(-x)); }
__device__ __forceinline__ float gelu_tanh(float x) { const float u = 0.7978845608028654f * (x + 0.044715f * x * x * x); return x * __builtin_amdgcn_rcpf(1.0f + __expf(-2.0f * u)); }
__device__ __forceinline__ unsigned pack_h2(float a, float b) { h16x2 h; h.x = (_Float16)a; h.y = (_Float16)b; return __builtin_bit_cast(unsigned, h); }

namespace pg8 {
constexpr int BM = 256, BK = 64, HALF = 128, HTB = HALF * BK * 2, STAGE_BYTES = 8 * HTB, NXCD = 8, WGM = 8;
__host__ __device__ __forceinline__ int lds_byte(int r, int c) { const int st = (r >> 4) * 2 + (c >> 5), rr = r & 15, cc = c & 31, ob = rr * 64 + cc * 2; return st * 1024 + (ob ^ (((ob >> 9) & 1) << 5)); }
__host__ __device__ __forceinline__ void stage_rc(int b, int& R, int& C) { const int st = b / 1024, sb = b % 1024, swz = sb ^ (((sb >> 9) & 1) << 5); R = (st >> 1) * 16 + swz / 64; C = (st & 1) * 32 + (swz % 64) / 2; }
__host__ __device__ __forceinline__ int perm32(int rho) { const int n = rho >> 4, i = rho & 15; return 8 * (i >> 2) + 4 * n + (i & 3); }

struct Unit { int pm, pn; };
struct Gemm { const bf16_t* A; const bf16_t* Bt; int M, N, K, lda, ldb; };

struct StaticOrder {
    int nM, nN, nwg, G, c, lat_only;
    __device__ void init(int M, int N, int G_, int c_, int lat_only_ = 0) { nM = M / BM; nN = N / BM; nwg = nM * nN; G = G_; c = c_; lat_only = lat_only_; }
    __device__ bool next(int i, Unit& u) const {
        const long L = (long)i * G + c; if (L >= nwg) return false;
        int wgid = (int)L; { const int q = nwg / NXCD, r = nwg % NXCD, xcd = wgid % NXCD, off = wgid / NXCD; wgid = (xcd < r ? xcd * (q + 1) : r * (q + 1) + (xcd - r) * q) + off; }
        const int nig = WGM * nN, gid = wgid / nig, fm = gid * WGM, gsz = (nM - fm) < WGM ? (nM - fm) : WGM;
        u.pm = fm + ((wgid % nig) % gsz); u.pn = (wgid % nig) / gsz; if (lat_only) u.pm = (u.pm >> 3) * 9 + 1 + (u.pm & 7); return true;
    }
};

template <class Epi, bool ALIGN_EPI>
__device__ __forceinline__ void gemm_phase(LAS unsigned char* lds, const Gemm g, const StaticOrder& S, const Epi& E, const int tid_in) {
    int tid = tid_in; asm volatile("" : "+v"(tid));
    const int wid = __builtin_amdgcn_readfirstlane(tid >> 6), lane = tid & 63, wr = wid >> 2, wc = wid & 3, fr = lane & 15, fq = lane >> 4;
    const int K = g.K, nt = K / BK;
    unsigned voffA[2], voffB[2];
#pragma unroll
    for (int i = 0; i < 2; ++i) { int R, C; stage_rc(tid * 16 + i * 8192, R, C); const int Rb = Epi::PERM ? ((R & ~31) + perm32(R & 31)) : R;
        voffA[i] = (unsigned)(R * g.lda + C) * 2u; voffB[i] = (unsigned)(Rb * g.ldb + C) * 2u;
        asm volatile("" : "+v"(voffA[i])); asm volatile("" : "+v"(voffB[i])); }
    const size_t kstep = (size_t)(BK * 2);
    const size_t hstepA = (size_t)HALF * g.lda * 2, hstepB = (size_t)HALF * g.ldb * 2;
    const size_t tstepA = 2 * hstepA, tstepB = 2 * hstepB;
    const unsigned ldsw = (unsigned)wid * 1024u;
    const int aoff = lds_byte(wr * 64 + fr, fq * 8), boff = lds_byte(wc * 32 + fr, fq * 8);
#define PG8_SA(b, h) (((b) * 2 + (h)) * HTB)
#define PG8_SB(b, h) ((4 + (b) * 2 + (h)) * HTB)
#define PG8_STAGE(bufoff, gbase, voff) do { const char* _gb = (const char*)(gbase); asm volatile("" : "+s"(_gb)); _Pragma("unroll") for (int _i = 0; _i < 2; ++_i) \
        __builtin_amdgcn_global_load_lds((const unsigned*)(_gb + (voff)[_i]), (LAS unsigned*)(lds + (bufoff) + ldsw + _i * 8192), 16, 0, 0); } while (0)
#define PG8_LDA(dst, b, h) do { _Pragma("unroll") for (int m = 0; m < 4; ++m) _Pragma("unroll") for (int k = 0; k < 2; ++k) dst[m][k] = *(const LAS bf16x8*)(lds + PG8_SA(b, h) + aoff + m * 2048 + k * 1024); } while (0)
#define PG8_LDB(dst, b, h) do { _Pragma("unroll") for (int n = 0; n < 2; ++n) _Pragma("unroll") for (int k = 0; k < 2; ++k) dst[n][k] = *(const LAS bf16x8*)(lds + PG8_SB(b, h) + boff + n * 2048 + k * 1024); } while (0)
#define PG8_MMA(ai, bj, At, Bt) do { __builtin_amdgcn_s_setprio(1); _Pragma("unroll") for (int m = 0; m < 4; ++m) _Pragma("unroll") for (int n = 0; n < 2; ++n) _Pragma("unroll") for (int k = 0; k < 2; ++k) \
        acc[ai][bj][m][n] = __builtin_amdgcn_mfma_f32_16x16x32_bf16(Bt[n][k], At[m][k], acc[ai][bj][m][n], 0, 0, 0); __builtin_amdgcn_s_setprio(0); } while (0)
#define PG8_WAIT_V(n) asm volatile("s_waitcnt vmcnt(" #n ")" ::: "memory")
#define PG8_WAIT_L(n) asm volatile("s_waitcnt lgkmcnt(" #n ")" ::: "memory")
#define PG8_BAR __builtin_amdgcn_s_barrier()
#define PG8_SCHED __builtin_amdgcn_sched_barrier(0)
    Unit cur, nxt; int ui = 0;
    if (!S.next(0, cur)) return;
    f32x4 acc[2][2][4][2];
#pragma unroll
    for (int a = 0; a < 2; ++a)
#pragma unroll
        for (int b = 0; b < 2; ++b)
#pragma unroll
            for (int m = 0; m < 4; ++m)
#pragma unroll
                for (int n = 0; n < 2; ++n) acc[a][b][m][n] = (f32x4){0.f, 0.f, 0.f, 0.f};
    bf16x8 At[4][2], B0[2][2], B1[2][2];
    const char* cA = (const char*)g.A + (size_t)cur.pm * tstepA; const char* cB = (const char*)g.Bt + (size_t)cur.pn * tstepB;
    PG8_STAGE(PG8_SB(0, 0), cB, voffB); PG8_STAGE(PG8_SB(0, 1), cB + hstepB, voffB); PG8_STAGE(PG8_SA(0, 0), cA, voffA); PG8_STAGE(PG8_SA(0, 1), cA + hstepA, voffA);
    if (wr == 1) PG8_BAR;
    PG8_WAIT_V(2); PG8_BAR;
    PG8_STAGE(PG8_SB(1, 0), cB + kstep, voffB); PG8_STAGE(PG8_SA(1, 0), cA + kstep, voffA); PG8_STAGE(PG8_SB(1, 1), cB + hstepB + kstep, voffB);
    PG8_WAIT_V(6); PG8_BAR;
    for (;;) {
        const bool has_next = S.next(ui + 1, nxt);
        const char* nA = has_next ? (const char*)g.A + (size_t)nxt.pm * tstepA : cA; const char* nB = has_next ? (const char*)g.Bt + (size_t)nxt.pn * tstepB : cB;
        for (int t = 0; t < nt; t += 2) {
            const bool last = (t == nt - 2);
            const char* a1 = cA + (size_t)(t + 1) * kstep;
            const char* a2 = last ? nA : cA + (size_t)(t + 2) * kstep; const char* b2 = last ? nB : cB + (size_t)(t + 2) * kstep;
            const char* a3 = a2 + kstep; const char* b3 = b2 + kstep;
            PG8_LDB(B0, 0, 0); PG8_LDB(B1, 0, 1); PG8_SCHED; PG8_LDA(At, 0, 0); PG8_STAGE(PG8_SA(1, 1), a1 + hstepA, voffA);
            PG8_WAIT_V(8); PG8_WAIT_L(0); PG8_BAR; PG8_MMA(0, 0, At, B0); PG8_MMA(0, 1, At, B1); PG8_BAR; PG8_SCHED;
            PG8_LDA(At, 0, 1); PG8_STAGE(PG8_SB(0, 0), b2, voffB); PG8_STAGE(PG8_SB(0, 1), b2 + hstepB, voffB); PG8_STAGE(PG8_SA(0, 0), a2, voffA);
            PG8_WAIT_V(8); PG8_WAIT_L(0); PG8_BAR; PG8_MMA(1, 0, At, B0); PG8_MMA(1, 1, At, B1); PG8_BAR; PG8_SCHED;
            PG8_LDB(B0, 1, 0); PG8_LDB(B1, 1, 1); PG8_SCHED; PG8_LDA(At, 1, 0); PG8_STAGE(PG8_SA(0, 1), a2 + hstepA, voffA);
            PG8_WAIT_V(8); PG8_WAIT_L(0); PG8_BAR; PG8_MMA(0, 0, At, B0); PG8_MMA(0, 1, At, B1); PG8_BAR; PG8_SCHED;
            PG8_LDA(At, 1, 1); PG8_STAGE(PG8_SB(1, 0), b3, voffB); PG8_STAGE(PG8_SB(1, 1), b3 + hstepB, voffB); PG8_STAGE(PG8_SA(1, 0), a3, voffA);
            PG8_WAIT_V(8); PG8_WAIT_L(0); PG8_BAR; PG8_MMA(1, 0, At, B0); PG8_MMA(1, 1, At, B1); PG8_BAR; PG8_SCHED;
        }
        if constexpr (ALIGN_EPI) { if (wr == 0) PG8_BAR; }
        PG8_SCHED; { int l2; asm volatile("v_mbcnt_lo_u32_b32 %0, -1, 0\n\tv_mbcnt_hi_u32_b32 %0, -1, %0" : "=v"(l2));
          E(acc, cur, wr, wc, l2 & 15, l2 >> 4); } PG8_SCHED;
        if (!has_next) break;
#pragma unroll
        for (int a = 0; a < 2; ++a)
#pragma unroll
            for (int b = 0; b < 2; ++b)
#pragma unroll
                for (int m = 0; m < 4; ++m)
#pragma unroll
                    for (int n = 0; n < 2; ++n) acc[a][b][m][n] = (f32x4){0.f, 0.f, 0.f, 0.f};
        cur = nxt; cA = nA; cB = nB; ++ui;
        if constexpr (ALIGN_EPI) { if (wr == 1) PG8_BAR; }
    }
    PG8_WAIT_V(0);
    if constexpr (!ALIGN_EPI) { if (wr == 0) PG8_BAR; }
    PG8_BAR;
#undef PG8_SA
#undef PG8_SB
#undef PG8_STAGE
#undef PG8_LDA
#undef PG8_LDB
#undef PG8_MMA
#undef PG8_WAIT_V
#undef PG8_WAIT_L
#undef PG8_BAR
#undef PG8_SCHED
}

template <int MODE> struct EpiStore {
    static constexpr bool PERM = true;
    bf16_t* O; int ldc; bf16_t *cq, *ckv, *kr, *u, *g;
    float* rss;
    const float* rs; float inv_n; int colscale;
    __device__ __forceinline__ void operator()(const f32x4 (&acc)[2][2][4][2], const Unit& un, int wr, int wc, int fr, int fq) const {
        const int row0 = un.pm * BM + wr * 64 + fr;
        if (MODE != 1) {
            int c0 = un.pn * BM + wc * 32 + 8 * fq;
            asm volatile("" : "+v"(c0));
            const int pitch = (MODE == 0) ? ldc : 768;
            bf16_t* p = (MODE == 0) ? O + c0 : O + (c0 >> 6) * 96 + (c0 & 63);
            const int bjstep = (MODE == 0) ? HALF : 192;
            f32x4 csc[2][2];
#pragma unroll
            for (int bj = 0; bj < 2; ++bj)
#pragma unroll
                for (int n = 0; n < 2; ++n) { csc[bj][n] = (f32x4){1.f, 1.f, 1.f, 1.f};
                    if (MODE == 0 && colscale) csc[bj][n] = *(const f32x4*)(rs + c0 + bj * HALF + 4 * n); }
            float rrows[2][4];
#pragma unroll
            for (int ai = 0; ai < 2; ++ai)
#pragma unroll
                for (int m = 0; m < 4; ++m) rrows[ai][m] = (rs != nullptr && !colscale) ? rs[row0 + ai * HALF + m * 16] : 1.0f;
#pragma unroll
            for (int ai = 0; ai < 2; ++ai)
#pragma unroll
                for (int m = 0; m < 4; ++m) {
                    bf16_t* rp = p + (size_t)(row0 + ai * HALF + m * 16) * pitch;
                    const float rrow = rrows[ai][m];
#pragma unroll
                    for (int bj = 0; bj < 2; ++bj) {
                        f32x4 v0 = acc[ai][bj][m][0] * rrow, v1 = acc[ai][bj][m][1] * rrow;
                        if (colscale) { v0 = v0 * csc[bj][0]; v1 = v1 * csc[bj][1]; }
                        u32x4 w; w.x = cvt_pk_bf16(v0[0], v0[1]); w.y = cvt_pk_bf16(v0[2], v0[3]); w.z = cvt_pk_bf16(v1[0], v1[1]); w.w = cvt_pk_bf16(v1[2], v1[3]);
                        *(u32x4*)(rp + bj * bjstep) = w;
                    }
                    asm volatile("" ::: "memory");
                }
            return;
        }
#pragma unroll
        for (int bj = 0; bj < 2; ++bj) {
            const int c0 = un.pn * BM + bj * HALF + wc * 32 + 8 * fq;
            bf16_t* p; int pitch;
            if (c0 < 384) { p = cq + c0; pitch = 384; }
            else if (c0 < 640) { p = ckv + (c0 - 384); pitch = 256; }
            else if (c0 < 672) { p = kr + (c0 - 640); pitch = 32; }
            else if (c0 < 1184) { p = u + (c0 - 672); pitch = 512; }
            else if (c0 < 1696) { p = g + (c0 - 1184); pitch = 512; }
            else { p = nullptr; pitch = 0; }
            if (p == nullptr) continue;
            const int grp = (c0 < 640) ? (c0 >> 5) : -1;
#pragma unroll
            for (int ai = 0; ai < 2; ++ai)
#pragma unroll
                for (int m = 0; m < 4; ++m) {
                    const f32x4 v0 = acc[ai][bj][m][0], v1 = acc[ai][bj][m][1];
                    u32x4 w; w.x = cvt_pk_bf16(v0[0], v0[1]); w.y = cvt_pk_bf16(v0[2], v0[3]); w.z = cvt_pk_bf16(v1[0], v1[1]); w.w = cvt_pk_bf16(v1[2], v1[3]);
                    *(u32x4*)(p + (size_t)(row0 + ai * HALF + m * 16) * pitch) = w;
                    if (grp >= 0) {
                        float sq = (v0[0] * v0[0] + v0[1] * v0[1]) + (v0[2] * v0[2] + v0[3] * v0[3]) + (v1[0] * v1[0] + v1[1] * v1[1]) + (v1[2] * v1[2] + v1[3] * v1[3]);
                        sq += __shfl_xor(sq, 16); sq += __shfl_xor(sq, 32);
                        if (fq == 0) rss[(size_t)(row0 + ai * HALF + m * 16) * 20 + grp] = sq;
                    }
                }
        }
    }
};
struct EpiGates {
    static constexpr bool PERM = false;
    const float *ba, *bx, *sp8;
    const bf16_t* uc; unsigned* ab;
    __device__ __forceinline__ void load_u(const Unit& un, int wr, int wc, int fr, int fq, u32x2 (&uu)[2][4]) const {
        const int row0 = un.pm * BM + wr * 64 + fr, ch = 64 * un.pn + 16 * wc + 4 * fq;
#pragma unroll
        for (int ai = 0; ai < 2; ++ai)
#pragma unroll
            for (int m = 0; m < 4; ++m) uu[ai][m] = *(const u32x2*)(uc + (size_t)(row0 + ai * HALF + m * 16) * 512 + ch);
    }
    __device__ __forceinline__ void operator()(const f32x4 (&acc)[2][2][4][2], const Unit& un, int wr, int wc, int fr, int fq, const u32x2 (&uu)[2][4]) const {
        const int row0 = un.pm * BM + wr * 64 + fr, ch = 64 * un.pn + 16 * wc + 4 * fq;
        f32x4 ba4_[2], bx4_[2], sp_[2];
#pragma unroll
        for (int d = 0; d < 2; ++d) { ba4_[d] = *(const f32x4*)(ba + d * 512 + ch); bx4_[d] = *(const f32x4*)(bx + d * 512 + ch); sp_[d] = *(const f32x4*)(sp8 + d * 512 + ch); }
#pragma unroll
        for (int bj = 0; bj < 2; ++bj) {
            const int d = bj;
            const f32x4 ba4 = ba4_[d], bx4 = bx4_[d], sp = sp_[d];
#pragma unroll
            for (int ai = 0; ai < 2; ++ai)
#pragma unroll
                for (int m = 0; m < 4; ++m) {
                    const int row = row0 + ai * HALF + m * 16;
                    const float uv[4] = {bf_lo(uu[ai][m].x), bf_hi(uu[ai][m].x), bf_lo(uu[ai][m].y), bf_hi(uu[ai][m].y)};
                    unsigned w[4];
#pragma unroll
                    for (int e = 0; e < 4; ++e) {
                        const float r = sigmoidf_(acc[ai][bj][m][0][e] + ba4[e]), ig = sigmoidf_(acc[ai][bj][m][1][e] + bx4[e]);
                        const float la = -r * sp[e];
                        const float bb = __builtin_amdgcn_sqrtf(fmaxf(1.0f - __expf(2.0f * la), 0.f)) * (ig * uv[e]);
                        w[e] = pack_h2(la, bb);
                    }
                    *(u32x4*)(ab + ((size_t)row * 2 + d) * 512 + ch) = (u32x4){w[0], w[1], w[2], w[3]};
                }
        }
    }
};
template <bool FINAL> struct EpiResid {
    static constexpr bool PERM = true;
    const float* gate;
    bf16_t* xr; float* out;
    __device__ __forceinline__ void operator()(const f32x4 (&acc)[2][2][4][2], const Unit& un, int wr, int wc, int fr, int fq) const {
        const int b = un.pm / 9, jj = un.pm % 9;
        const float* gp = gate + (size_t)(jj == 0 ? 16 : b) * NMOD;
        const int row0 = un.pm * BM + wr * 64 + fr, col0 = un.pn * BM + wc * 32 + 8 * fq;
        f32x4 g4[2][2];
#pragma unroll
        for (int bj = 0; bj < 2; ++bj)
#pragma unroll
            for (int n = 0; n < 2; ++n) g4[bj][n] = *(const f32x4*)(gp + col0 + bj * HALF + n * 4);
        u32x4 xin[2][4][2];
#pragma unroll
        for (int ai = 0; ai < 2; ++ai)
#pragma unroll
            for (int m = 0; m < 4; ++m)
#pragma unroll
                for (int bj = 0; bj < 2; ++bj) xin[ai][m][bj] = *(const u32x4*)(xr + (size_t)(row0 + ai * HALF + m * 16) * DM + col0 + bj * HALF);
#pragma unroll
        for (int ai = 0; ai < 2; ++ai) {
#pragma unroll
            for (int m = 0; m < 4; ++m) {
                const int row = row0 + ai * HALF + m * 16;
                bf16_t* xp = xr + (size_t)row * DM + col0;
#pragma unroll
                for (int bj = 0; bj < 2; ++bj) {
                    const u32x4 xi = xin[ai][m][bj];
                    const f32x4 x0 = (f32x4){bf_lo(xi.x), bf_hi(xi.x), bf_lo(xi.y), bf_hi(xi.y)}, x1 = (f32x4){bf_lo(xi.z), bf_hi(xi.z), bf_lo(xi.w), bf_hi(xi.w)};
                    const f32x4 y0 = x0 + g4[bj][0] * acc[ai][bj][m][0], y1 = x1 + g4[bj][1] * acc[ai][bj][m][1];
                    if (FINAL) {
                        float* op = out + ((size_t)b * SEQ + (size_t)(jj - 1) * 256 + (row - un.pm * BM)) * DM + col0 + bj * HALF;
                        *(f32x4*)op = y0; *(f32x4*)(op + 4) = y1;
                    } else {
                        u32x4 w; w.x = cvt_pk_bf16(y0[0], y0[1]); w.y = cvt_pk_bf16(y0[2], y0[3]); w.z = cvt_pk_bf16(y1[0], y1[1]); w.w = cvt_pk_bf16(y1[2], y1[3]);
                        *(u32x4*)(xp + bj * HALF) = w;
                    }
                }
            }
            asm volatile("" ::: "memory");
        }
    }
};
struct EpiSwiglu {
    static constexpr bool PERM = false;
    bf16_t* ff;
    __device__ __forceinline__ void operator()(const f32x4 (&acc)[2][2][4][2], const Unit& un, int wr, int wc, int fr, int fq) const {
        const int row0 = un.pm * BM + wr * 64 + fr;
#pragma unroll
        for (int bj = 0; bj < 2; ++bj) {
            const int j0 = (un.pn * 8 + bj * 4 + wc) * 16 + 4 * fq;
#pragma unroll
            for (int ai = 0; ai < 2; ++ai)
#pragma unroll
                for (int m = 0; m < 4; ++m) {
                    const f32x4 gt = acc[ai][bj][m][0], up = acc[ai][bj][m][1];
                    float v[4];
#pragma unroll
                    for (int e = 0; e < 4; ++e) v[e] = gt[e] * sigmoidf_(gt[e]) * up[e];
                    u32x2 w; w.x = cvt_pk_bf16(v[0], v[1]); w.y = cvt_pk_bf16(v[2], v[3]);
                    *(u32x2*)(ff + (size_t)(row0 + ai * HALF + m * 16) * DFF + j0) = w;
                }
        }
    }
};
}

__device__ __forceinline__ void gates_phase(LAS unsigned char* lds, const bf16_t* uc, const bf16_t* wg, const pg8::EpiGates& E, float* sums, const int tid_in, const int bid, const int G) {
    int tid = tid_in; asm volatile("" : "+v"(tid));
    const int wid = __builtin_amdgcn_readfirstlane(tid >> 6), lane = tid & 63, wr = wid >> 2, wc = wid & 3, fr = lane & 15, fq = lane >> 4;
    constexpr int P = 144, NU = (T / 256) * 8;
    LAS unsigned char* As = lds; LAS unsigned char* Bs = lds + 256 * P;
    const int lrow = tid >> 3, c8 = tid & 7;
    u32x4 ra[4], rb[4];
    int unit = bid;
    if (unit < NU) {
        const int pm = unit >> 3, nb = unit & 7;
#pragma unroll
        for (int i = 0; i < 4; ++i) { ra[i] = *(const u32x4*)(uc + (size_t)(pm * 256 + 64 * i + lrow) * LRU + 64 * nb + 8 * c8); rb[i] = *(const u32x4*)(wg + (size_t)(nb * 256 + 64 * i + lrow) * 64 + 8 * c8); }
    }
    while (unit < NU) {
        const int pm = unit >> 3, nb = unit & 7;
#pragma unroll
        for (int i = 0; i < 4; ++i) { *(LAS u32x4*)(As + (64 * i + lrow) * P + 16 * c8) = ra[i]; *(LAS u32x4*)(Bs + (64 * i + lrow) * P + 16 * c8) = rb[i]; }
        __syncthreads();
        const int nxt = unit + G;
        if (nxt < NU) {
            const int pm2 = nxt >> 3, nb2 = nxt & 7;
#pragma unroll
            for (int i = 0; i < 4; ++i) { ra[i] = *(const u32x4*)(uc + (size_t)(pm2 * 256 + 64 * i + lrow) * LRU + 64 * nb2 + 8 * c8); rb[i] = *(const u32x4*)(wg + (size_t)(nb2 * 256 + 64 * i + lrow) * 64 + 8 * c8); }
        }
        const pg8::Unit un{pm, nb};
        u32x2 uu[2][4]; E.load_u(un, wr, wc, fr, fq, uu);
        f32x4 acc[2][2][4][2];
#pragma unroll
        for (int ai = 0; ai < 2; ++ai) {
            bf16x8 At[4][2];
#pragma unroll
            for (int m = 0; m < 4; ++m)
#pragma unroll
                for (int k = 0; k < 2; ++k) At[m][k] = *(const LAS bf16x8*)(As + (128 * ai + 64 * wr + 16 * m + fr) * P + 64 * k + 16 * fq);
#pragma unroll
            for (int bj = 0; bj < 2; ++bj) {
                bf16x8 Bf[2][2];
#pragma unroll
                for (int n = 0; n < 2; ++n)
#pragma unroll
                    for (int k = 0; k < 2; ++k) Bf[n][k] = *(const LAS bf16x8*)(Bs + (128 * bj + 32 * wc + 16 * n + fr) * P + 64 * k + 16 * fq);
#pragma unroll
                for (int m = 0; m < 4; ++m)
#pragma unroll
                    for (int n = 0; n < 2; ++n) {
                        f32x4 c = (f32x4){0.f, 0.f, 0.f, 0.f};
#pragma unroll
                        for (int k = 0; k < 2; ++k) c = __builtin_amdgcn_mfma_f32_16x16x32_bf16(Bf[n][k], At[m][k], c, 0, 0, 0);
                        acc[ai][bj][m][n] = c;
                    }
            }
        }
        __syncthreads();
        E(acc, un, wr, wc, fr, fq, uu);
        asm volatile("s_waitcnt vmcnt(0)" ::: "memory"); __syncthreads();
        {
            const int cl = wid >> 1, d = wid & 1, ch = 64 * nb + lane, t0 = pm * 256 + cl * 64;
            const unsigned* abp = E.ab + ((size_t)t0 * 2 + d) * 512 + ch;
            float hs = 0.f, sl = 0.f;
            unsigned av[64];
#pragma unroll
            for (int i = 0; i < 64; ++i) av[i] = abp[(size_t)i * 1024];
            if (d == 0) {
#pragma unroll
                for (int i = 0; i < 64; ++i) { const h16x2 v = __builtin_bit_cast(h16x2, av[i]); const float la = (float)v.x; hs = __expf(la) * hs + (float)v.y; sl += la; }
            } else {
#pragma unroll
                for (int i = 63; i >= 0; --i) { const h16x2 v = __builtin_bit_cast(h16x2, av[i]); const float la = (float)v.x; hs = __expf(la) * hs + (float)v.y; sl += la; }
            }
            const int bc = (pm / 9) * NCHUNK + (pm % 9) * 4 + cl;
            *(float2*)(sums + (((size_t)bc * 2 + d) * 512 + ch) * 2) = make_float2(sl, hs);
        }
        unit = nxt;
    }
}

struct WSrc { const float* p; int ld, klo, khi; const float* kg; };
__device__ __forceinline__ WSrc wsrc(const Args& a, int l, int mat, int n) {
    WSrc s; s.p = nullptr; s.ld = 0; s.klo = 0; s.khi = 1 << 30; s.kg = nullptr;
    switch (mat) {
        case 0: if (n < IN_DIM) { s.p = a.in[8] + (size_t)l * DM * IN_DIM + n; s.ld = IN_DIM; } break;
        case 1: s.p = a.in[10] + (size_t)l * QR * 768 + n; s.ld = 768; s.kg = a.in[9] + (size_t)l * QR; break;
        case 2: s.p = a.in[12] + (size_t)l * KVR * 1024 + (n >> 6) * 128 + (n & 63); s.ld = 1024; s.kg = a.in[11] + (size_t)l * KVR; break;
        case 3: s.p = a.in[12] + (size_t)l * KVR * 1024 + (n >> 6) * 128 + 64 + (n & 63); s.ld = 1024; s.kg = a.in[11] + (size_t)l * KVR; break;
        case 4: case 5: {
            const int nb = n >> 8, c = n & 255, d = c >> 7, chg = (c >> 5) & 3, kind = (c >> 4) & 1, c16 = c & 15, e = 16 * chg + c16;
            const float* w = kind ? a.in[19] : a.in[17];
            s.p = w + ((((size_t)l * 2 + d) * 8 + nb) * 64) * 64 + e; s.ld = 64; } break;
        case 6: s.p = a.in[22] + (size_t)l * DM * DM + n; s.ld = DM; break;
        case 7: { const int g32 = n >> 5, kind = (n >> 4) & 1, c16 = n & 15, jc = g32 * 16 + c16; s.p = a.in[23] + (size_t)l * DM * 2 * DFF + (kind ? DFF + jc : jc); s.ld = 2 * DFF; } break;
        default: s.p = a.in[24] + (size_t)l * DFF * DM + n; s.ld = DM; break;
    }
    return s;
}
__device__ __forceinline__ void wt_item(const Args& a, int l, int mat, int K, int N, bf16_t* WT, LAS float* scr, int item, int lane) {
    const int nblk = N / 32, kb = item / nblk, nb = item % nblk, k0 = 64 * kb, n0 = 32 * nb;
    const int n4 = (lane & 7) * 4, kr = lane >> 3;
    const WSrc s = wsrc(a, l, mat, n0 + n4);
    f32x4 v[8];
#pragma unroll
    for (int i = 0; i < 8; ++i) { const int k = k0 + 8 * i + kr;
        v[i] = (f32x4){0.f, 0.f, 0.f, 0.f}; if (s.p != nullptr && k >= s.klo && k < s.khi) { v[i] = *(const f32x4*)(s.p + (size_t)(k - s.klo) * s.ld); if (s.kg != nullptr) v[i] = v[i] * s.kg[k]; } }
#pragma unroll
    for (int i = 0; i < 8; ++i) { LAS float* d = scr + (8 * i + kr) * 33 + n4; d[0] = v[i][0]; d[1] = v[i][1]; d[2] = v[i][2]; d[3] = v[i][3]; }
    asm volatile("s_waitcnt lgkmcnt(0)" ::: "memory");
    const int c = lane & 7;
#pragma unroll
    for (int j = 0; j < 4; ++j) { const int n = (lane >> 3) + 8 * j; const LAS float* sp = scr + (8 * c) * 33 + n;
        u32x4 o; o.x = cvt_pk_bf16(sp[0 * 33], sp[1 * 33]); o.y = cvt_pk_bf16(sp[2 * 33], sp[3 * 33]); o.z = cvt_pk_bf16(sp[4 * 33], sp[5 * 33]); o.w = cvt_pk_bf16(sp[6 * 33], sp[7 * 33]);
        *(u32x4*)(WT + (size_t)(n0 + n) * K + k0 + 8 * c) = o; }
    asm volatile("s_waitcnt lgkmcnt(0)" ::: "memory");
}
__device__ __forceinline__ void convert_weights(const Args& a, int l, LAS unsigned char* lds, int gw, int NGW, int wid, int lane) {
    LAS float* scr = (LAS float*)(lds + wid * 8704);
    bf16_t* wt = (bf16_t*)(a.ws + WS_WT);
    const size_t ffo = (l & 1) ? (WS_FFO_ALT - WS_WT) : WT_FFO;
    const int Ks[9] = {1024, 384, 256, 256, 64, 64, 1024, 1024, 2816};
    const int Ns[9] = {IN_PAD, 768, 512, 512, 2048, 0, 1024, 5632, 1024};
    const size_t offs[9] = {WT_IN, WT_UQ, WT_KN, WT_VT, WT_G0, WT_G1, WT_OUT, WT_FFI, ffo};
#pragma unroll
    for (int mat = 0; mat < 9; ++mat) {
        const int K = Ks[mat], N = Ns[mat], items = (K / 64) * (N / 32);
        for (int it = gw; it < items; it += NGW) wt_item(a, l, mat, K, N, wt + offs[mat] / 2, scr, it, lane);
    }
}

__device__ __forceinline__ void mod_phase(const Args& a, LAS unsigned char* lds, const int tid, const int ubeg, const int uend, const int first, const int stride) {
    LAS float* s = (LAS float*)lds;
    LAS float* red = (LAS float*)(lds + 17 * 1024 * 4);
    for (int i = tid; i < 17 * 1024; i += 512) { const int r = i >> 10, k = i & 1023; const float v = r < 16 ? a.in[1][r * 1024 + k] : a.in[3][k]; s[i] = v * sigmoidf_(v); }
    __syncthreads();
    float* mod = (float*)(a.ws + WS_MOD);
    const int ks = tid >> 6, cl = tid & 63;
    for (int unit = ubeg + first; unit < uend; unit += stride) {
        const int l = unit / 96, n0 = (unit % 96) * 64;
        const float* w = a.in[4] + (size_t)l * DM * NMOD + n0 + cl;
        float acc[17];
#pragma unroll
        for (int r = 0; r < 17; ++r) acc[r] = 0.f;
        for (int kk = 0; kk < 128; kk += 8) {
            const int k = ks * 128 + kk;
            float wv[8];
#pragma unroll
            for (int j = 0; j < 8; ++j) wv[j] = w[(size_t)(k + j) * NMOD];
#pragma unroll
            for (int j4 = 0; j4 < 2; ++j4)
#pragma unroll
                for (int r = 0; r < 17; ++r) { const f32x4 sv = *(const LAS f32x4*)(s + r * 1024 + k + 4 * j4); acc[r] += sv[0] * wv[4 * j4] + sv[1] * wv[4 * j4 + 1] + sv[2] * wv[4 * j4 + 2] + sv[3] * wv[4 * j4 + 3]; }
        }
#pragma unroll
        for (int r = 0; r < 17; ++r) red[(ks * 17 + r) * 64 + cl] = acc[r];
        __syncthreads();
        for (int i = tid; i < 17 * 64; i += 512) { const int r = i >> 6, c = i & 63; float v = a.in[5][(size_t)l * NMOD + n0 + c];
#pragma unroll
            for (int q = 0; q < 8; ++q) v += red[(q * 17 + r) * 64 + c];
            mod[((size_t)l * 17 + r) * NMOD + n0 + c] = v; }
        __syncthreads();
    }
}

__device__ __forceinline__ void norm_rows(int t_begin, int t_end, const bf16_t* xr, const float* modl, int sh_off, int sc_off, const float* gain, bf16_t* H, int lane, float* rss_zero) {
    if (rss_zero != nullptr) { for (int t = t_begin + lane; t < t_end; t += 64) { rss_zero[t] = 0.f; rss_zero[T + t] = 0.f; } }
    f32x4 g[4];
#pragma unroll
    for (int q = 0; q < 4; ++q) g[q] = *(const f32x4*)(gain + 8 * lane + 512 * (q >> 1) + 4 * (q & 1));
    constexpr int NT = 3;
    for (int t0 = t_begin; t0 < t_end; t0 += NT) {
        u32x4 xi[NT][2]; f32x4 sh[NT][4], sc[NT][4];
#pragma unroll
        for (int r = 0; r < NT; ++r) {
            const int t = (t0 + r < t_end) ? t0 + r : t0;
            const int b = t / TPB, j = t % TPB;
            const float* mp = modl + (size_t)(j < CTX ? 16 : b) * NMOD;
#pragma unroll
            for (int q = 0; q < 2; ++q) xi[r][q] = *(const u32x4*)(xr + (size_t)t * DM + 8 * lane + 512 * q);
#pragma unroll
            for (int q = 0; q < 4; ++q) { const int k = 8 * lane + 512 * (q >> 1) + 4 * (q & 1); sh[r][q] = *(const f32x4*)(mp + sh_off + k); sc[r][q] = *(const f32x4*)(mp + sc_off + k); }
        }
#pragma unroll
        for (int r = 0; r < NT; ++r) {
            if (t0 + r >= t_end) break;
            f32x4 v[4];
#pragma unroll
            for (int q = 0; q < 2; ++q) { const u32x4 w = xi[r][q]; v[2 * q] = (f32x4){bf_lo(w.x), bf_hi(w.x), bf_lo(w.y), bf_hi(w.y)}; v[2 * q + 1] = (f32x4){bf_lo(w.z), bf_hi(w.z), bf_lo(w.w), bf_hi(w.w)}; }
            float ss = 0.f;
#pragma unroll
            for (int q = 0; q < 4; ++q) ss += v[q][0] * v[q][0] + v[q][1] * v[q][1] + v[q][2] * v[q][2] + v[q][3] * v[q][3];
            const float rstd = rsqrtf(wave_sum(ss) * (1.0f / DM) + EPS);
#pragma unroll
            for (int q = 0; q < 2; ++q) {
                const f32x4 y0 = (v[2 * q] * rstd * g[2 * q]) * (sc[r][2 * q] + 1.0f) + sh[r][2 * q], y1 = (v[2 * q + 1] * rstd * g[2 * q + 1]) * (sc[r][2 * q + 1] + 1.0f) + sh[r][2 * q + 1];
                u32x4 w; w.x = cvt_pk_bf16(y0[0], y0[1]); w.y = cvt_pk_bf16(y0[2], y0[3]); w.z = cvt_pk_bf16(y1[0], y1[1]); w.w = cvt_pk_bf16(y1[2], y1[3]);
                *(u32x4*)(H + (size_t)(t0 + r) * DM + 8 * lane + 512 * q) = w;
            }
        }
    }
}
__device__ __forceinline__ void load_residual(const float* x, const float* ctx, bf16_t* xr, int t_begin, int t_end, int lane) {
    for (int t0 = t_begin; t0 < t_end; t0 += 2) {
        f32x4 v[2][4];
#pragma unroll
        for (int r = 0; r < 2; ++r) {
            const int t = (t0 + r < t_end) ? t0 + r : t0; const int b = t / TPB, j = t % TPB;
            const float* src = (j < CTX) ? ctx + ((size_t)b * CTX + j) * DM : x + ((size_t)b * SEQ + (j - CTX)) * DM;
#pragma unroll
            for (int q = 0; q < 4; ++q) v[r][q] = *(const f32x4*)(src + 8 * lane + 512 * (q >> 1) + 4 * (q & 1));
        }
#pragma unroll
        for (int r = 0; r < 2; ++r) {
            if (t0 + r >= t_end) break;
#pragma unroll
            for (int q = 0; q < 2; ++q) { const f32x4 a0 = v[r][2 * q], a1 = v[r][2 * q + 1];
                u32x4 w; w.x = cvt_pk_bf16(a0[0], a0[1]); w.y = cvt_pk_bf16(a0[2], a0[3]); w.z = cvt_pk_bf16(a1[0], a1[1]); w.w = cvt_pk_bf16(a1[2], a1[3]);
                *(u32x4*)(xr + (size_t)(t0 + r) * DM + 8 * lane + 512 * q) = w; }
        }
    }
}
__device__ __forceinline__ void norm_rows_in(int t_begin, int t_end, const float* x, const float* ctx, bf16_t* xr, const float* modl, int sh_off, int sc_off, const float* gain, bf16_t* H, int lane) {
    f32x4 g[4];
#pragma unroll
    for (int q = 0; q < 4; ++q) g[q] = *(const f32x4*)(gain + 8 * lane + 512 * (q >> 1) + 4 * (q & 1));
    for (int t0 = t_begin; t0 < t_end; t0 += 2) {
        f32x4 vin[2][4], sh[2][4], sc[2][4];
#pragma unroll
        for (int r = 0; r < 2; ++r) {
            const int t = (t0 + r < t_end) ? t0 + r : t0; const int b = t / TPB, j = t % TPB;
            const float* src = (j < CTX) ? ctx + ((size_t)b * CTX + j) * DM : x + ((size_t)b * SEQ + (j - CTX)) * DM;
            const float* mp = modl + (size_t)(j < CTX ? 16 : b) * NMOD;
#pragma unroll
            for (int q = 0; q < 4; ++q) { const int k = 8 * lane + 512 * (q >> 1) + 4 * (q & 1); vin[r][q] = *(const f32x4*)(src + k); sh[r][q] = *(const f32x4*)(mp + sh_off + k); sc[r][q] = *(const f32x4*)(mp + sc_off + k); }
        }
#pragma unroll
        for (int r = 0; r < 2; ++r) {
            if (t0 + r >= t_end) break;
            f32x4 v[4]; float ss = 0.f;
#pragma unroll
            for (int q = 0; q < 2; ++q) { const f32x4 a0 = vin[r][2 * q], a1 = vin[r][2 * q + 1];
                u32x4 w; w.x = cvt_pk_bf16(a0[0], a0[1]); w.y = cvt_pk_bf16(a0[2], a0[3]); w.z = cvt_pk_bf16(a1[0], a1[1]); w.w = cvt_pk_bf16(a1[2], a1[3]);
                *(u32x4*)(xr + (size_t)(t0 + r) * DM + 8 * lane + 512 * q) = w;
                v[2 * q] = (f32x4){bf_lo(w.x), bf_hi(w.x), bf_lo(w.y), bf_hi(w.y)}; v[2 * q + 1] = (f32x4){bf_lo(w.z), bf_hi(w.z), bf_lo(w.w), bf_hi(w.w)}; }
#pragma unroll
            for (int q = 0; q < 4; ++q) ss += v[q][0] * v[q][0] + v[q][1] * v[q][1] + v[q][2] * v[q][2] + v[q][3] * v[q][3];
            const float rstd = rsqrtf(wave_sum(ss) * (1.0f / DM) + EPS);
#pragma unroll
            for (int q = 0; q < 2; ++q) {
                const f32x4 y0 = (v[2 * q] * rstd * g[2 * q]) * (sc[r][2 * q] + 1.0f) + sh[r][2 * q], y1 = (v[2 * q + 1] * rstd * g[2 * q + 1]) * (sc[r][2 * q + 1] + 1.0f) + sh[r][2 * q + 1];
                u32x4 w; w.x = cvt_pk_bf16(y0[0], y0[1]); w.y = cvt_pk_bf16(y0[2], y0[3]); w.z = cvt_pk_bf16(y1[0], y1[1]); w.w = cvt_pk_bf16(y1[2], y1[3]);
                *(u32x4*)(H + (size_t)(t0 + r) * DM + 8 * lane + 512 * q) = w;
            }
        }
    }
}
__device__ __forceinline__ void mid_rows(const Args& a, int l, int t_begin, int t_end, int lane) {
    const bf16_t* u = (const bf16_t*)(a.ws + WS_U); bf16_t* ucb = (bf16_t*)(a.ws + WS_UC);
    const float* rssp = (const float*)(a.ws + WS_RSS); float* rstd = (float*)(a.ws + WS_RSTD);
    const int ch = 8 * lane;
    float cw[4][8], cb[8];
#pragma unroll
    for (int q = 0; q < 4; ++q)
#pragma unroll
        for (int i = 0; i < 8; ++i) cw[q][i] = a.in[15][((size_t)l * 4 + q) * LRU + ch + i];
#pragma unroll
    for (int i = 0; i < 8; ++i) cb[i] = a.in[16][(size_t)l * LRU + ch + i];
    for (int t0 = t_begin; t0 < t_end; t0 += 2) {
        u32x4 uu[2][4];
#pragma unroll
        for (int r = 0; r < 2; ++r) {
            const int t = (t0 + r < t_end) ? t0 + r : t0;
            const int j = t % TPB; const int tl = (j < CTX) ? j : j - CTX, len = (j < CTX) ? CTX : SEQ;
#pragma unroll
            for (int q = 0; q < 4; ++q) { const int tt = tl - 1 + q; uu[r][q] = (tt >= 0 && tt < len) ? *(const u32x4*)(u + (size_t)(t - 1 + q) * LRU + ch) : (u32x4){0u, 0u, 0u, 0u}; }
        }
#pragma unroll
        for (int r = 0; r < 2; ++r) {
            if (t0 + r >= t_end) break;
            const int t = t0 + r;
            {
                const float pv = (lane < 20) ? rssp[(size_t)t * 20 + lane] : 0.f;
                const float sq = wave_sum(lane < 12 ? pv : 0.f), skv = wave_sum(lane >= 12 ? pv : 0.f);
                if (lane == 0) { rstd[t] = rsqrtf(sq * (1.0f / QR) + EPS); rstd[T + t] = rsqrtf(skv * (1.0f / KVR) + EPS); }
            }
            float o[8];
#pragma unroll
            for (int i = 0; i < 8; ++i) o[i] = cb[i];
#pragma unroll
            for (int q = 0; q < 4; ++q) { const u32x4 w = uu[r][q];
                o[0] += bf_lo(w.x) * cw[q][0]; o[1] += bf_hi(w.x) * cw[q][1]; o[2] += bf_lo(w.y) * cw[q][2]; o[3] += bf_hi(w.y) * cw[q][3];
                o[4] += bf_lo(w.z) * cw[q][4]; o[5] += bf_hi(w.z) * cw[q][5]; o[6] += bf_lo(w.w) * cw[q][6]; o[7] += bf_hi(w.w) * cw[q][7]; }
            u32x4 rr; rr.x = cvt_pk_bf16(o[0], o[1]); rr.y = cvt_pk_bf16(o[2], o[3]); rr.z = cvt_pk_bf16(o[4], o[5]); rr.w = cvt_pk_bf16(o[6], o[7]);
            *(u32x4*)(ucb + (size_t)t * LRU + ch) = rr;
        }
    }
}
__device__ __forceinline__ void fin_rows(const Args& a, int l, int t_begin, int t_end, int lane) {
    const int h = lane >> 3, sub = lane & 7; const bool rl = sub < 4;
    float gk0[8], gk1[8];
    { const float* gk = a.in[14] + (size_t)l * DQK;
#pragma unroll
      for (int i = 0; i < 8; ++i) { gk0[i] = gk[8 * sub + i]; gk1[i] = rl ? gk[64 + 8 * sub + i] : 0.f; } }
    float inv[8];
#pragma unroll
    for (int i = 0; i < 8; ++i) inv[i] = __builtin_amdgcn_exp2f(-(float)i * (13.287712379549449f / 8.0f));
    const float sgn = (sub & 1) ? 1.0f : -1.0f;
    bf16_t* Kb = (bf16_t*)(a.ws + WS_K); const bf16_t* KR = (const bf16_t*)(a.ws + WS_KR);
    constexpr int NT = 3;
    for (int t0 = t_begin; t0 < t_end; t0 += NT) {
        u32x4 ka[NT], kr4[NT];
#pragma unroll
        for (int r = 0; r < NT; ++r) { const int t = (t0 + r < t_end) ? t0 + r : t0;
            ka[r] = *(const u32x4*)(Kb + (size_t)t * 768 + h * 96 + 8 * sub); kr4[r] = rl ? *(const u32x4*)(KR + (size_t)t * 32 + 8 * sub) : (u32x4){0u, 0u, 0u, 0u}; }
#pragma unroll
        for (int r = 0; r < NT; ++r) {
            if (t0 + r >= t_end) break;
            const int t = t0 + r, j = t % TPB; const bool lat = j >= CTX; const int tl = j - CTX;
            const float pos = lat ? (float)((sub < 2) ? (tl >> 6) : (tl & 63)) : 0.f;
            const u32x4 wa = ka[r], wr = kr4[r];
            float x[8] = {bf_lo(wa.x), bf_hi(wa.x), bf_lo(wa.y), bf_hi(wa.y), bf_lo(wa.z), bf_hi(wa.z), bf_lo(wa.w), bf_hi(wa.w)};
            float y[8] = {bf_lo(wr.x), bf_hi(wr.x), bf_lo(wr.y), bf_hi(wr.y), bf_lo(wr.z), bf_hi(wr.z), bf_lo(wr.w), bf_hi(wr.w)};
            float ss = 0.f;
#pragma unroll
            for (int i = 0; i < 8; ++i) ss += x[i] * x[i] + y[i] * y[i];
            ss += __shfl_xor(ss, 1); ss += __shfl_xor(ss, 2); ss += __shfl_xor(ss, 4);
            const float rstd = rsqrtf(ss * (1.0f / DQK) + EPS);
#pragma unroll
            for (int i = 0; i < 8; ++i) { x[i] *= rstd * gk0[i]; y[i] *= rstd * gk1[i]; }
            float o[8];
#pragma unroll
            for (int i = 0; i < 8; ++i) { const float ang = pos * inv[i]; const float py = __shfl_xor(y[i], 1); o[i] = y[i] * __cosf(ang) + py * (__sinf(ang) * sgn); }
            bf16_t* base = Kb + (size_t)t * 768 + h * 96;
            u32x4 w; w.x = cvt_pk_bf16(x[0], x[1]); w.y = cvt_pk_bf16(x[2], x[3]); w.z = cvt_pk_bf16(x[4], x[5]); w.w = cvt_pk_bf16(x[6], x[7]);
            *(u32x4*)(base + 8 * sub) = w;
            if (rl) { u32x4 rr; rr.x = cvt_pk_bf16(o[0], o[1]); rr.y = cvt_pk_bf16(o[2], o[3]); rr.z = cvt_pk_bf16(o[4], o[5]); rr.w = cvt_pk_bf16(o[6], o[7]);
                      *(u32x4*)(base + 64 + 8 * sub) = rr; }
        }
    }
}

constexpr float SSHIFT = 8.0f;
constexpr int KPITCH = 208, VPITCH = 144, KBUF = 64 * KPITCH, VBUF = 64 * VPITCH;
__device__ __forceinline__ void attn_unit(LAS unsigned char* lds, const bf16_t* Q, const bf16_t* Kb, const bf16_t* VT, bf16_t* cat, const float* qgain, const bool rope_on, int h, int qrow0, int krow0, int nk, const int tid) {
    const int wid = tid >> 6, lane = tid & 63, l32 = lane & 31, hi = lane >> 5;
    const bf16_t* qp = Q + (size_t)(qrow0 + wid * 32 + l32) * 768 + h * 96 + 8 * hi;
    bf16x8 qf[6];
    {
        u32x4 raw[6]; float ss = 0.f;
#pragma unroll
        for (int ks = 0; ks < 6; ++ks) { raw[ks] = *(const u32x4*)(qp + 16 * ks);
            const float a0 = bf_lo(raw[ks].x), a1 = bf_hi(raw[ks].x), a2 = bf_lo(raw[ks].y), a3 = bf_hi(raw[ks].y), a4 = bf_lo(raw[ks].z), a5 = bf_hi(raw[ks].z), a6 = bf_lo(raw[ks].w), a7 = bf_hi(raw[ks].w);
            ss += (a0 * a0 + a1 * a1) + (a2 * a2 + a3 * a3) + (a4 * a4 + a5 * a5) + (a6 * a6 + a7 * a7); }
        ss += __shfl_xor(ss, 32);
        const float rstd = rsqrtf(ss * (1.0f / DQK) + EPS) * QSCALE;
        const int tl = (qrow0 - krow0 - CTX) + wid * 32 + l32;
        const float sgn = hi ? 1.0f : -1.0f;
#pragma unroll
        for (int ks = 0; ks < 6; ++ks) {
            const f32x4 g0 = *(const f32x4*)(qgain + 16 * ks + 8 * hi), g1 = *(const f32x4*)(qgain + 16 * ks + 8 * hi + 4);
            float y[8] = {bf_lo(raw[ks].x) * rstd * g0[0], bf_hi(raw[ks].x) * rstd * g0[1], bf_lo(raw[ks].y) * rstd * g0[2], bf_hi(raw[ks].y) * rstd * g0[3],
                          bf_lo(raw[ks].z) * rstd * g1[0], bf_hi(raw[ks].z) * rstd * g1[1], bf_lo(raw[ks].w) * rstd * g1[2], bf_hi(raw[ks].w) * rstd * g1[3]};
            if (ks >= 4) {
                const float pos = rope_on ? (float)((ks == 4) ? (tl >> 6) : (tl & 63)) : 0.f;
#pragma unroll
                for (int i = 0; i < 8; ++i) { const float ang = pos * __builtin_amdgcn_exp2f(-(float)i * (13.287712379549449f / 8.0f)); const float py = __shfl_xor(y[i], 32);
                    y[i] = y[i] * __cosf(ang) + py * (__sinf(ang) * sgn); }
            }
            u32x4 w; w.x = cvt_pk_bf16(y[0], y[1]); w.y = cvt_pk_bf16(y[2], y[3]); w.z = cvt_pk_bf16(y[4], y[5]); w.w = cvt_pk_bf16(y[6], y[7]);
            qf[ks] = __builtin_bit_cast(bf16x8, w);
        }
    }
    f32x16 o0, o1;
#pragma unroll
    for (int i = 0; i < 16; ++i) { o0[i] = 0.f; o1[i] = 0.f; }
    float lsum = 0.f;
    const int ntiles = nk / 64;
    const int kr0 = tid / 12, kc0 = tid % 12, kr1 = (tid + 512) / 12, kc1 = (tid + 512) % 12;
    const int vr = tid >> 3, vc = tid & 7;
    const bf16_t* kg0 = Kb + (size_t)(krow0 + kr0) * 768 + h * 96 + kc0 * 8;
    const bf16_t* kg1 = Kb + (size_t)(krow0 + kr1) * 768 + h * 96 + kc1 * 8;
    const bf16_t* vg = VT + (size_t)(h * 64 + vr) * T + krow0 + vc * 8;
    const int kl0 = kr0 * KPITCH + kc0 * 16, kl1 = kr1 * KPITCH + kc1 * 16;
    const int vl = 3 * KBUF + vr * VPITCH + (vc >> 1) * 32 + (vc & 1) * 8;
    const bool two = tid < 256;
    u32x4 rk0, rk1 = (u32x4){0, 0, 0, 0}, rv;
#define ATT_LDK(tt) do { rk0 = *(const u32x4*)(kg0 + (size_t)(tt) * 64 * 768); if (two) rk1 = *(const u32x4*)(kg1 + (size_t)(tt) * 64 * 768); } while (0)
#define ATT_STK(slot) do { *(LAS u32x4*)(lds + (slot) * KBUF + kl0) = rk0; if (two) *(LAS u32x4*)(lds + (slot) * KBUF + kl1) = rk1; } while (0)
#define ATT_LDV(tt) do { rv = *(const u32x4*)(vg + (tt) * 64); } while (0)
#define ATT_STV(slot) do { *(LAS u32x2*)(lds + (slot) * VBUF + vl) = (u32x2){rv.x, rv.y}; *(LAS u32x2*)(lds + (slot) * VBUF + vl + 16) = (u32x2){rv.z, rv.w}; } while (0)
#define ATT_QK(S0, S1, slot) do { const LAS unsigned char* kb = lds + (slot) * KBUF; _Pragma("unroll") for (int i = 0; i < 16; ++i) { S0[i] = -SSHIFT; S1[i] = -SSHIFT; } \
        _Pragma("unroll") for (int ks = 0; ks < 6; ++ks) { \
            const bf16x8 a0 = *(const LAS bf16x8*)(kb + l32 * KPITCH + ks * 32 + hi * 16); const bf16x8 a1 = *(const LAS bf16x8*)(kb + (32 + l32) * KPITCH + ks * 32 + hi * 16); \
            S0 = __builtin_amdgcn_mfma_f32_32x32x16_bf16(a0, qf[ks], S0, 0, 0, 0); S1 = __builtin_amdgcn_mfma_f32_32x32x16_bf16(a1, qf[ks], S1, 0, 0, 0); } } while (0)
#define ATT_EXP1(C0, C1, fi) do { if ((fi) < 16) { C0[(fi) & 15] = __builtin_amdgcn_exp2f(C0[(fi) & 15]); ps += C0[(fi) & 15]; } else if ((fi) < 32) { C1[(fi) & 15] = __builtin_amdgcn_exp2f(C1[(fi) & 15]); ps += C1[(fi) & 15]; } } while (0)
#define ATT_STEP(C0, C1, N0, N1, tt, ks_next, ks_store, vs_cur, vs_store) do { \
        const bool h1 = (tt) + 1 < ntiles, h2 = (tt) + 2 < ntiles; \
        if (h2) ATT_LDK((tt) + 2); \
        if (h1) ATT_LDV((tt) + 1); \
        float ps = 0.f; \
        { const LAS unsigned char* kb = lds + (ks_next) * KBUF; _Pragma("unroll") for (int i = 0; i < 16; ++i) { N0[i] = -SSHIFT; N1[i] = -SSHIFT; } \
          __builtin_amdgcn_sched_barrier(0); __builtin_amdgcn_s_setprio(1);     \
          _Pragma("unroll") for (int ks = 0; ks < 6; ++ks) {     \
            const bf16x8 a0 = *(const LAS bf16x8*)(kb + l32 * KPITCH + ks * 32 + hi * 16); const bf16x8 a1 = *(const LAS bf16x8*)(kb + (32 + l32) * KPITCH + ks * 32 + hi * 16); \
            N0 = __builtin_amdgcn_mfma_f32_32x32x16_bf16(a0, qf[ks], N0, 0, 0, 0); N1 = __builtin_amdgcn_mfma_f32_32x32x16_bf16(a1, qf[ks], N1, 0, 0, 0); \
            _Pragma("unroll") for (int e_ = 0; e_ < 6; ++e_) ATT_EXP1(C0, C1, ks * 6 + e_); \
            __builtin_amdgcn_sched_barrier(0); } } \
        lsum += ps; \
        bf16x8 pf[4]; \
        _Pragma("unroll") for (int jj = 0; jj < 2; ++jj) { u32x4 w0, w1; \
            w0.x = cvt_pk_bf16(C0[8 * jj + 0], C0[8 * jj + 1]); w0.y = cvt_pk_bf16(C0[8 * jj + 2], C0[8 * jj + 3]); w0.z = cvt_pk_bf16(C0[8 * jj + 4], C0[8 * jj + 5]); w0.w = cvt_pk_bf16(C0[8 * jj + 6], C0[8 * jj + 7]); \
            w1.x = cvt_pk_bf16(C1[8 * jj + 0], C1[8 * jj + 1]); w1.y = cvt_pk_bf16(C1[8 * jj + 2], C1[8 * jj + 3]); w1.z = cvt_pk_bf16(C1[8 * jj + 4], C1[8 * jj + 5]); w1.w = cvt_pk_bf16(C1[8 * jj + 6], C1[8 * jj + 7]); \
            pf[jj] = __builtin_bit_cast(bf16x8, w0); pf[2 + jj] = __builtin_bit_cast(bf16x8, w1); } \
        { const LAS unsigned char* vb = lds + 3 * KBUF + (vs_cur) * VBUF; \
          _Pragma("unroll") for (int jj = 0; jj < 4; ++jj) { \
            const bf16x8 v0 = *(const LAS bf16x8*)(vb + l32 * VPITCH + jj * 32 + hi * 16); const bf16x8 v1 = *(const LAS bf16x8*)(vb + (32 + l32) * VPITCH + jj * 32 + hi * 16); \
            o0 = __builtin_amdgcn_mfma_f32_32x32x16_bf16(v0, pf[jj], o0, 0, 0, 0); o1 = __builtin_amdgcn_mfma_f32_32x32x16_bf16(v1, pf[jj], o1, 0, 0, 0); } } \
        __builtin_amdgcn_s_setprio(0); \
        if (h2) ATT_STK(ks_store); \
        if (h1) ATT_STV(vs_store); \
        __syncthreads(); } while (0)
    ATT_LDK(0); ATT_LDV(0);
    const u32x4 kx0 = *(const u32x4*)(kg0 + (size_t)64 * 768); u32x4 kx1 = (u32x4){0, 0, 0, 0}; if (two) kx1 = *(const u32x4*)(kg1 + (size_t)64 * 768);
    ATT_STK(0); ATT_STV(0);
    rk0 = kx0; rk1 = kx1; ATT_STK(1);
    __syncthreads();
    f32x16 sa0, sa1, sb0, sb1;
    ATT_QK(sa0, sa1, 0);
    int k0s = 0;
    for (int t = 0; t < ntiles; t += 2) {
        const int k1s = (k0s == 2) ? 0 : k0s + 1, k2s = (k1s == 2) ? 0 : k1s + 1;
        ATT_STEP(sa0, sa1, sb0, sb1, t, k1s, k2s, 0, 1);
        ATT_STEP(sb0, sb1, sa0, sa1, t + 1, k2s, k0s, 1, 0);
        k0s = k2s;
    }
#undef ATT_LDK
#undef ATT_STK
#undef ATT_LDV
#undef ATT_STV
#undef ATT_QK
#undef ATT_STEP
#undef ATT_EXP1
    const float ltot = lsum + __shfl_xor(lsum, 32), inv = __builtin_amdgcn_rcpf(ltot);
    bf16_t* op = cat + (size_t)(qrow0 + wid * 32 + l32) * DM + h * 64 + 4 * hi;
#pragma unroll
    for (int q = 0; q < 4; ++q) {
        u32x2 w; w.x = cvt_pk_bf16(o0[4 * q] * inv, o0[4 * q + 1] * inv); w.y = cvt_pk_bf16(o0[4 * q + 2] * inv, o0[4 * q + 3] * inv);
        *(u32x2*)(op + 8 * q) = w;
        w.x = cvt_pk_bf16(o1[4 * q] * inv, o1[4 * q + 1] * inv); w.y = cvt_pk_bf16(o1[4 * q + 2] * inv, o1[4 * q + 3] * inv);
        *(u32x2*)(op + 32 + 8 * q) = w;
    }
}
__device__ __forceinline__ void attn_phase(const Args& a, int l, LAS unsigned char* lds, const int tid, const int bid) {
    const bf16_t* Q = (const bf16_t*)(a.ws + WS_Q); const bf16_t* Kb = (const bf16_t*)(a.ws + WS_K); const bf16_t* VT = (const bf16_t*)(a.ws + WS_VT);
    bf16_t* cat = (bf16_t*)a.out;
    const int nunits = (l == DEPTH - 1) ? 1024 : 1152;
    for (int i = bid; i < nunits; i += gridDim.x) {
        int pair, qb;
        if (i < 1024) { const int r = i >> 8, c = i & 255; pair = r * 32 + (c & 7) * 4 + (c >> 6); qb = ((c >> 3) & 7) + 1; }
        else { pair = i - 1024; qb = 0; }
        const int b = pair >> 3, h = pair & 7;
        attn_unit(lds, Q, Kb, VT, cat, a.in[13] + (size_t)l * DQK, qb != 0, h, b * TPB + qb * 256, b * TPB, qb == 0 ? CTX : TPB, tid);
    }
}

__device__ __forceinline__ void scan_s1(const Args& a, const int tid, const int bid) {
    const unsigned* ab = (const unsigned*)(a.ws + WS_AB); float* sums = (float*)(a.ws + WS_SUMS);
    const int ch = tid;
    for (int it = bid; it < NB * NCHUNK * 2; it += gridDim.x) {
        const int d = it & 1, bc = it >> 1, b = bc / NCHUNK, c = bc % NCHUNK, t0 = b * TPB + c * 64;
        float hs = 0.f, sl = 0.f;
#pragma unroll 8
        for (int i = 0; i < 64; ++i) {
            const int t = d == 0 ? t0 + i : t0 + 63 - i;
            const h16x2 v = __builtin_bit_cast(h16x2, ab[((size_t)t * 2 + d) * 512 + ch]);
            const float la = (float)v.x, bb = (float)v.y;
            hs = __expf(la) * hs + bb; sl += la;
        }
        *(float2*)(sums + (((size_t)bc * 2 + d) * 512 + ch) * 2) = make_float2(sl, hs);
    }
}
__device__ __forceinline__ void scan_s3(const Args& a, const int tid, const int bid, const int last) {
    const unsigned* ab = (const unsigned*)(a.ws + WS_AB); const float* sums = (const float*)(a.ws + WS_SUMS);
    const bf16_t* g = (const bf16_t*)(a.ws + WS_G); bf16_t* cat = (bf16_t*)a.out;
    const int ch = tid;
    const bool deal = (gridDim.x == 256);
    for (int k = 0; k < 3; ++k) {
        int bc = bid + (int)gridDim.x * k;
        if (deal && k == 2) bc = (bid >= 128 && bid < 192) ? bid - 128 + 512 : NB * NCHUNK;
        if (bc >= NB * NCHUNK) break;
        const int b = bc / NCHUNK, c = bc % NCHUNK, t0 = b * TPB + c * 64;
        if (last && c < 4) continue;
        const float* sb = sums + (size_t)b * NCHUNK * 2 * 512 * 2;
        float hf = 0.f, hb = 0.f;
        {
            float2 v[NCHUNK];
#pragma unroll
            for (int k = 0; k < NCHUNK; ++k) v[k] = *(const float2*)(sb + (((size_t)k * 2 + 0) * 512 + ch) * 2);
#pragma unroll
            for (int k = 0; k < NCHUNK; ++k) { const bool use = k < c; const float aa = use ? __expf(v[k].x) : 1.0f, bb = use ? v[k].y : 0.f; hf = aa * hf + bb; }
            const int pos = (c < 4) ? 3 - c : 4 + (NCHUNK - 1 - c);
#pragma unroll
            for (int k = 0; k < NCHUNK; ++k) { const int cc = (k < 4) ? 3 - k : NCHUNK + 3 - k; v[k] = *(const float2*)(sb + (((size_t)cc * 2 + 1) * 512 + ch) * 2); }
#pragma unroll
            for (int k = 0; k < NCHUNK; ++k) { const bool use = k < pos; const float aa = use ? __expf(v[k].x) : 1.0f, bb = use ? v[k].y : 0.f; hb = aa * hb + bb; }
        }
        float hfs[64];
#pragma unroll
        for (int i = 0; i < 64; ++i) {
            const h16x2 v = __builtin_bit_cast(h16x2, __builtin_nontemporal_load(ab + ((size_t)(t0 + i) * 2 + 0) * 512 + ch));
            hf = __expf((float)v.x) * hf + (float)v.y; hfs[i] = hf;
        }
#pragma unroll
        for (int i0 = 48; i0 >= 0; i0 -= 16) {
            unsigned av[16]; bf16_t gv[16];
#pragma unroll
            for (int j = 0; j < 16; ++j) { av[j] = __builtin_nontemporal_load(ab + ((size_t)(t0 + i0 + j) * 2 + 1) * 512 + ch); gv[j] = __builtin_nontemporal_load(g + (size_t)(t0 + i0 + j) * 512 + ch); }
#pragma unroll
            for (int j = 15; j >= 0; --j) {
                const h16x2 v = __builtin_bit_cast(h16x2, av[j]);
                hb = __expf((float)v.x) * hb + (float)v.y;
                cat[(size_t)(t0 + i0 + j) * DM + 512 + ch] = f2bf((hfs[i0 + j] + hb) * gelu_tanh(bf1(gv[j])));
            }
        }
    }
}

#define XB_TMO      128
#define XB_XCNT(j)  (256  + 64 * (j))
#define XB_XSUB(j)  (1280 + 64 * (j))
#define XB_XGEN(j)  (2304 + 64 * (j))
#define XB_TOP      3328
#define XB_TOPGEN   3392
#define XCD_BAR_WORDS 3456
#define XB_SPIN_CAP (1u << 18)

__device__ __forceinline__ unsigned xb_ld(unsigned* p)              { return __hip_atomic_load(p, __ATOMIC_RELAXED, __HIP_MEMORY_SCOPE_AGENT); }
__device__ __forceinline__ unsigned xb_add(unsigned* p, unsigned v) { return __hip_atomic_fetch_add(p, v, __ATOMIC_RELAXED, __HIP_MEMORY_SCOPE_AGENT); }
__device__ __forceinline__ unsigned xb_xcc_id() { return (unsigned)__builtin_amdgcn_s_getreg((3 << 11) | 20) & 0xFu; }
#define XB_SPIN(cond, bar) do { unsigned _sp = 0; while (cond) { __builtin_amdgcn_s_sleep(1); \
    if ((++_sp & 255u) == 0u) { if (xb_ld(&(bar)[XB_TMO])) break; if (_sp > XB_SPIN_CAP) { atomicAdd(&(bar)[XB_TMO], 1u); break; } } } } while (0)

struct XcdBarrier {
    unsigned* bar; unsigned x;
    volatile LAS unsigned* st;
};

__device__ __forceinline__ XcdBarrier xcd_barrier_post(unsigned* bar, volatile LAS unsigned* st) {
    XcdBarrier b; b.bar = bar; b.x = xb_xcc_id(); b.st = st;
    if (threadIdx.x == 0) (void)xb_add(&bar[XB_XCNT(b.x)], 1u);
    return b;
}
__device__ __forceinline__ void xcd_barrier_complete(unsigned* bar, unsigned x, unsigned& nloc, unsigned& nx) {
    const unsigned G = gridDim.x * gridDim.y * gridDim.z;
    unsigned sum, cnt, mine, sp = 0u;
    for (;;) {
        sum = 0u; cnt = 0u; mine = 0u;
#pragma unroll
        for (unsigned j = 0; j < 16; ++j) { const unsigned c = xb_ld(&bar[XB_XCNT(j)]); sum += c; cnt += (c > 0u) ? 1u : 0u; mine = (j == x) ? c : mine; }
        if (sum == G) break;
        __builtin_amdgcn_s_sleep(1);
        if ((++sp & 255u) == 0u) { if (xb_ld(&bar[XB_TMO])) break; if (sp > XB_SPIN_CAP) { atomicAdd(&bar[XB_TMO], 1u); break; } }
    }
    nloc = mine > 0u ? mine : 1u; nx = cnt > 0u ? cnt : 1u;
}

__device__ __forceinline__ void xcd_barrier(const XcdBarrier& b) {
    asm volatile("s_waitcnt vmcnt(0)" ::: "memory");
    __syncthreads();
    if (threadIdx.x == 0) {
        unsigned* bar = b.bar;
        __builtin_amdgcn_s_waitcnt(0);
        unsigned nloc = b.st[0], nx = b.st[1];
        if (nloc == 0u) { xcd_barrier_complete(bar, b.x, nloc, nx); b.st[0] = nloc; b.st[1] = nx; }
        const unsigned old = xb_add(&bar[XB_XSUB(b.x)], 1u);
        const unsigned gen = old / nloc;
        if (old + 1u == (gen + 1u) * nloc) {
            __builtin_amdgcn_fence(__ATOMIC_RELEASE, "agent");
            asm volatile("s_waitcnt vmcnt(0)" ::: "memory");
            const unsigned og = xb_add(&bar[XB_TOP], 1u);
            const unsigned tg = og / nx;
            if (og + 1u == (tg + 1u) * nx) xb_add(&bar[XB_TOPGEN], 1u);
            else XB_SPIN(xb_ld(&bar[XB_TOPGEN]) == tg, bar);
            __builtin_amdgcn_fence(__ATOMIC_ACQUIRE, "agent");
            xb_add(&bar[XB_XGEN(b.x)], 1u);
            asm volatile("s_waitcnt vmcnt(0)" ::: "memory");
        } else {
            XB_SPIN(xb_ld(&bar[XB_XGEN(b.x)]) == gen, bar);
            __builtin_amdgcn_fence(__ATOMIC_ACQUIRE, "agent");
            asm volatile("s_waitcnt vmcnt(0)" ::: "memory");
        }
    }
    __syncthreads();
}


__device__ __forceinline__ int fresh_lane() { int l; asm volatile("v_mbcnt_lo_u32_b32 %0, -1, 0\n\tv_mbcnt_hi_u32_b32 %0, -1, %0" : "=v"(l)); return l; }
#ifndef PHASE_MASK
#define PHASE_MASK 0xFFF
#endif
#ifndef P3SEL
#define P3SEL 7
#endif
#define PH_ON(k) (((PHASE_MASK) >> (k)) & 1)
#ifndef PROBE_REP_MASK
#define PROBE_REP_MASK 0
#endif
#ifndef PROBE_CASE
#define PROBE_CASE -1
#endif
#ifndef PROBE_N
#define PROBE_N 2
#endif
#define REPS(k) for (int rep_ = 0; rep_ < ((PROBE_CASE == (k)) ? PROBE_N : 1); ++rep_)
constexpr int PPL = 10, PPLX = PPL + __builtin_popcount(PROBE_REP_MASK), NPHASE = 1 + DEPTH * PPLX;
typedef const __attribute__((address_space(4))) Args* ArgsP;
#define LD_IN(k) la.in[k] = ap->in[k]
__global__ void __launch_bounds__(512) fwd_kernel(Args a_unused) {
    extern __shared__ __attribute__((aligned(16))) unsigned char lds_raw[];
    LAS unsigned char* lds = (LAS unsigned char*)lds_raw;
    const int G = gridDim.x, NGW = G * 8;
    const int wid0 = __builtin_amdgcn_readfirstlane((int)threadIdx.x >> 6);
    ArgsP ap0 = (ArgsP)__builtin_amdgcn_kernarg_segment_ptr();
    const int ph_lo = ap0->ph_lo, ph_hi = ap0->ph_hi;
    volatile LAS unsigned* bst = (volatile LAS unsigned*)(lds + LDS_BARST);
    if (threadIdx.x < 2) bst[threadIdx.x] = 0u;
    __syncthreads();
    const XcdBarrier xbar = xcd_barrier_post((unsigned*)(ap0->ws + WS_BAR), bst);
    for (int ph = ph_lo; ph < ph_hi; ++ph) {
        if (ph > ph_lo) { if (ph == ph_lo + 1) cg::this_grid().sync(); else xcd_barrier(xbar); }
        ArgsP ap = ap0; asm volatile("" : "+s"(ap));
        int wid_ = wid0, bid_ = blockIdx.x; asm volatile("" : "+s"(wid_)); asm volatile("" : "+s"(bid_));
        const int wid = wid_, bid = bid_, gw = bid * 8 + wid;
#define TID (wid * 64 + fresh_lane())
#define LANE (fresh_lane())
        Args la; la.ws = ap->ws; la.out = ap->out;
        unsigned char* ws = la.ws;
        if (ph == 0) { if (PH_ON(11)) { LD_IN(1); LD_IN(3); LD_IN(4); LD_IN(5); mod_phase(la, lds, TID, 0, 96, bid, G); } continue; }
        const int l = (ph - 1) / PPLX; int lp = (ph - 1) % PPLX; if (!PROBE_REP_MASK && lp >= 6) lp += 1;
        int probe_first = 0;
        if (PROBE_REP_MASK) { const int e = lp; int cnt = 0; for (int q = 0; q < PPL; ++q) { const int n = 1 + ((PROBE_REP_MASK >> q) & 1); if (e < cnt + n) { lp = q; probe_first = (n == 2 && e == cnt) ? 1 : 0; break; } cnt += n; } }
        const float* modl = (const float*)(ws + WS_MOD) + (size_t)l * 17 * NMOD;
        bf16_t* wt = (bf16_t*)(ws + WS_WT);
        bf16_t* H = (bf16_t*)la.out;
        bf16_t* xr = (bf16_t*)(ws + WS_XR);
        pg8::StaticOrder S;
        const int last = (l == DEPTH - 1) ? 1 : 0;
        switch (lp) {
        case 0: if (PH_ON(0)) REPS(0) {
            LD_IN(8); LD_IN(9); LD_IN(10); LD_IN(11); LD_IN(12); LD_IN(17); LD_IN(19); LD_IN(22); LD_IN(23); LD_IN(24);
            if (l == 0) convert_weights(la, l, lds, gw, NGW, wid, LANE);
            if (bid == G - 1) { const float* lam = ap->in[21] + (size_t)l * 1024; float* sp8 = (float*)(ws + WS_SP);
                for (int i = TID; i < 1024; i += 512) { const float z = -lam[i]; const float e = __expf(-fabsf(z)); const float lp = e < 0.03f ? e * (1.0f - e * (0.5f - e * (0.33333334f - 0.25f * e))) : __logf(1.0f + e); sp8[i] = 8.0f * (fmaxf(z, 0.f) + lp); } }
            const float* gain = ap->in[6] + (size_t)l * DM;
            { const int per = (T + NGW - 1) / NGW, tb = gw * per, te = (tb + per < T) ? tb + per : T;
              if (l == 0) norm_rows_in(tb, te, ap->in[0], ap->in[2], xr, modl, 0, DM, gain, H, LANE); else norm_rows(tb, te, xr, modl, 0, DM, gain, H, LANE, nullptr); }
        } break;
        case 1: if (PH_ON(1)) REPS(1) {
            pg8::Gemm g{H, wt + WT_IN / 2, T, IN_PAD, DM, DM, DM}; S.init(T, IN_PAD, G, bid);
            pg8::EpiStore<1> E{nullptr, 0, (bf16_t*)(ws + WS_CQ), (bf16_t*)(ws + WS_CKV), (bf16_t*)(ws + WS_KR), (bf16_t*)(ws + WS_U), (bf16_t*)(ws + WS_G), (float*)(ws + WS_RSS), nullptr, 0.f, 0};
            pg8::gemm_phase<pg8::EpiStore<1>, true>(lds, g, S, E, TID);
        } break;
        case 2: if (PH_ON(2)) REPS(2) { LD_IN(15); LD_IN(16); const int per = (T + NGW - 1) / NGW, tb = gw * per, te = (tb + per < T) ? tb + per : T; mid_rows(la, l, tb, te, LANE); } break;
        case 3: if (PH_ON(3)) REPS(3) {
            if (P3SEL & 1) { pg8::Gemm g{(const bf16_t*)(ws + WS_CQ), wt + WT_UQ / 2, T, 768, QR, QR, QR}; S.init(last ? TLAT : T, 768, G, bid, last);
              pg8::EpiStore<0> E{(bf16_t*)(ws + WS_Q), 768, nullptr, nullptr, nullptr, nullptr, nullptr, nullptr, (const float*)(ws + WS_RSTD), 1.0f / QR, 0};
              pg8::gemm_phase<pg8::EpiStore<0>, true>(lds, g, S, E, TID); }
            if (P3SEL & 2) { pg8::Gemm g{(const bf16_t*)(ws + WS_CKV), wt + WT_KN / 2, T, 512, KVR, KVR, KVR}; S.init(T, 512, G, (bid + 80) % G);
              pg8::EpiStore<2> E{(bf16_t*)(ws + WS_K), 768, nullptr, nullptr, nullptr, nullptr, nullptr, nullptr, (const float*)(ws + WS_RSTD) + T, 1.0f / KVR, 0};
              pg8::gemm_phase<pg8::EpiStore<2>, true>(lds, g, S, E, TID); }
            if (P3SEL & 4) { pg8::Gemm g{wt + WT_VT / 2, (const bf16_t*)(ws + WS_CKV), 512, T, KVR, KVR, KVR}; S.init(512, T, G, (bid + 48) % G);
              pg8::EpiStore<0> E{(bf16_t*)(ws + WS_VT), T, nullptr, nullptr, nullptr, nullptr, nullptr, nullptr, (const float*)(ws + WS_RSTD) + T, 1.0f / KVR, 1};
              pg8::gemm_phase<pg8::EpiStore<0>, true>(lds, g, S, E, TID); }
        } break;
        case 4: if (PH_ON(4)) {
            LD_IN(14);
            const float* ba = ap->in[18] + (size_t)l * 1024; const float* bx = ap->in[20] + (size_t)l * 1024;
            for (int half_ = 0; half_ < 2; ++half_) if ((half_ ^ (bid & 1)) == 0) {
            { pg8::EpiGates E{ba, bx, (const float*)(ws + WS_SP), (const bf16_t*)(ws + WS_UC), (unsigned*)(ws + WS_AB)};
              REPS(4) gates_phase(lds, (const bf16_t*)(ws + WS_UC), wt + WT_G0 / 2, E, (float*)(ws + WS_SUMS), TID, bid, G); }
            } else {
            if (!probe_first) { const int per = (T + NGW - 1) / NGW, tb = gw * per, te = (tb + per < T) ? tb + per : T; fin_rows(la, l, tb, te, LANE); }
            }
        } break;
        case 5: if (PH_ON(5)) REPS(5) { LD_IN(13);
            for (int half_ = 0; half_ < 2; ++half_) { if ((half_ ^ (bid & 1)) == 0) attn_phase(la, l, lds, TID, bid); else { REPS(6) scan_s3(la, TID, bid, last); } } } break;
        case 7: if (PH_ON(7)) {
            pg8::Gemm g{H, wt + WT_OUT / 2, T, DM, DM, DM, DM}; S.init(last ? TLAT : T, DM, G, bid, last);
            pg8::EpiResid<false> E{modl + 2 * DM, xr, nullptr};
            pg8::gemm_phase<pg8::EpiResid<false>, true>(lds, g, S, E, TID);
            if (!last) {
                const int nx = ((T / 256) * (DM / 256)) % G, idle = G - nx;
                if (bid >= nx && bid - nx < 96) { LD_IN(1); LD_IN(3); LD_IN(4); LD_IN(5); mod_phase(la, lds, TID, 96 * (l + 1), 96 * (l + 2), bid - nx, idle); }
            }
        } break;
        case 8: if (PH_ON(8)) REPS(8) { const float* gain = ap->in[7] + (size_t)l * DM; const int per = (T + NGW - 1) / NGW, tb = gw * per, te = (tb + per < T) ? tb + per : T; norm_rows(tb, te, xr, modl, 3 * DM, 4 * DM, gain, H, LANE, nullptr); } break;
        case 9: if (PH_ON(9)) REPS(9) {
            pg8::Gemm g{H, wt + WT_FFI / 2, T, 2 * DFF, DM, DM, DM}; S.init(last ? TLAT : T, 2 * DFF, G, bid, last);
            pg8::EpiSwiglu E{(bf16_t*)(ws + WS_FF)};
            pg8::gemm_phase<pg8::EpiSwiglu, true>(lds, g, S, E, TID);
        } break;
        default: if (PH_ON(10)) {
            pg8::Gemm g{(const bf16_t*)(ws + WS_FF), wt + ((l & 1) ? (WS_FFO_ALT - WS_WT) : WT_FFO) / 2, T, DM, DFF, DFF, DFF}; S.init(last ? TLAT : T, DM, G, bid, last);
            if (last) { pg8::EpiResid<true> E{modl + 5 * DM, xr, la.out}; pg8::gemm_phase<pg8::EpiResid<true>, true>(lds, g, S, E, TID); }
            else { pg8::EpiResid<false> E{modl + 5 * DM, xr, nullptr}; pg8::gemm_phase<pg8::EpiResid<false>, true>(lds, g, S, E, TID); }
            if (!last) {
                const int nx = ((T / 256) * (DM / 256)) % G;
                if (bid >= nx) { LD_IN(8); LD_IN(9); LD_IN(10); LD_IN(11); LD_IN(12); LD_IN(17); LD_IN(19); LD_IN(22); LD_IN(23); LD_IN(24);
                    convert_weights(la, l + 1, lds, (bid - nx) * 8 + wid, (G - nx) * 8, wid, LANE); }
            }
        } break;
        }
    }
}

#undef TID
#undef LANE
extern "C" void kernel_launch(void* const* d_in, const int* in_sizes, int n_in, void* d_out, int out_size, void* d_ws, size_t ws_size, hipStream_t stream) {
    static int grid = 0;
    if (grid == 0) {
        if (n_in != 25 || out_size != NB * SEQ * DM || ws_size < WS_END) { fprintf(stderr, "kernel_launch: unexpected shapes (n_in %d out %d ws %zu)\n", n_in, out_size, ws_size); grid = -1; return; }
        int dev = 0, cus = 0, per_cu = 0;
        hipGetDevice(&dev); hipDeviceGetAttribute(&cus, hipDeviceAttributeMultiprocessorCount, dev);
        hipFuncSetAttribute((const void*)fwd_kernel, hipFuncAttributeMaxDynamicSharedMemorySize, LDS_BYTES);
        hipOccupancyMaxActiveBlocksPerMultiprocessor(&per_cu, (const void*)fwd_kernel, 512, LDS_BYTES);
        if (per_cu < 1) { fprintf(stderr, "kernel_launch: occupancy query says %d blocks per CU\n", per_cu); per_cu = 1; }
        grid = cus * per_cu;
        (void)hipGetLastError();
    }
    if (grid < 0) return;
    Args a{};
    for (int i = 0; i < 25; ++i) a.in[i] = (const float*)d_in[i];
    a.out = (float*)d_out; a.ws = (unsigned char*)d_ws;
    if (hipMemsetAsync((unsigned char*)d_ws + WS_BAR, 0, BAR_BYTES, stream) != hipSuccess) { fprintf(stderr, "kernel_launch: hipMemsetAsync of the barrier words failed\n"); return; }
#if MK_MULTI_LAUNCH
    for (int ph = 0; ph < NPHASE; ++ph) { a.ph_lo = ph; a.ph_hi = ph + 1; hipLaunchKernelGGL(fwd_kernel, dim3(grid), dim3(512), LDS_BYTES, stream, a); }
#else
    a.ph_lo = 0; a.ph_hi = NPHASE;
    void* args[] = {&a};
    hipError_t e = hipLaunchCooperativeKernel((const void*)fwd_kernel, dim3(grid), dim3(512), args, LDS_BYTES, stream);
    if (e != hipSuccess) fprintf(stderr, "cooperative launch failed: %s (grid %d)\n", hipGetErrorString(e), grid);
#endif
}
```
